# Optimizing an MI355X kernel written in HIP

```python
import jax, jax.numpy as jnp
from jax import lax
import numpy as np


D_MODEL = 1024
BATCH = 2
SEQ = 16384
DEPTH = 2

CTX_LEN = 256
GRID_W = 64
N_HEADS = 8
QK_NOPE = 64
QK_ROPE = 32
QK_HEAD = QK_NOPE + QK_ROPE
V_HEAD = 64
Q_LORA = 384
KV_LORA = 256
KV_IN = KV_LORA + QK_ROPE
ROPE_AXIS_DIM = QK_ROPE // 2
ROPE_THETA = 10000.0
Q_BLOCK = 128
POOL_WINDOWS = (2, 4, 8, 16)
POOL_GROUPS = 4
POOL_GROUP = 128
POOL_WIDTH = POOL_GROUPS * POOL_GROUP
AB_IN = Q_LORA + KV_IN + POOL_WIDTH
MIX_OUT = N_HEADS * V_HEAD + POOL_WIDTH
D_CONV = 1024
CONV_WIDTH = 3
PEER_HEADS = 8
PEER_N_KEYS = 128
PEER_TOPK = 16
PEER_D_KEY = 128
PEER_N_EXPERTS = PEER_N_KEYS * PEER_N_KEYS
PEER_CHUNK = 128
EPS = 1e-6
N_EVEN = (DEPTH + 1) // 2
N_ODD = DEPTH // 2

kernel_name = 'hybrid_mla_pool_shortconv_peer'


def rmsnorm(x, g):
    xf = x.astype(jnp.float32)
    y = xf * lax.rsqrt(jnp.mean(xf * xf, axis=-1, keepdims=True) + EPS)
    return (y * g.astype(jnp.float32)).astype(x.dtype)


def modulate(xn, shift, scale):
    return xn * (1 + scale) + shift


def axial_rope_tables(L):
    rows = L // GRID_W
    row = jnp.broadcast_to(jnp.arange(rows, dtype=jnp.float32)[:, None], (rows, GRID_W)).reshape(-1)
    col = jnp.broadcast_to(jnp.arange(GRID_W, dtype=jnp.float32)[None, :], (rows, GRID_W)).reshape(-1)
    inv = ROPE_THETA ** (-jnp.arange(0, ROPE_AXIS_DIM, 2, dtype=jnp.float32) / ROPE_AXIS_DIM)
    ang = jnp.stack([row[:, None] * inv, col[:, None] * inv], axis=1)
    return jnp.cos(ang), jnp.sin(ang)


def apply_axial_rope(x, cos, sin):
    half = ROPE_AXIS_DIM // 2
    xs = x.reshape(x.shape[:-1] + (2, 2, half))
    x1, x2 = xs[..., 0, :], xs[..., 1, :]
    cs = cos[:, None].astype(x.dtype)
    sn = sin[:, None].astype(x.dtype)
    out = jnp.stack([x1 * cs - x2 * sn, x2 * cs + x1 * sn], axis=-2)
    return out.reshape(x.shape)


def rope_heads(t, cos, sin):
    return jnp.concatenate([t[..., :QK_NOPE], apply_axial_rope(t[..., QK_NOPE:], cos, sin)], axis=-1)


def mla_queries(h_q, q_a_norm, q_b_w, q_norm):
    B, L = h_q.shape[:2]
    q = (rmsnorm(h_q, q_a_norm) @ q_b_w).reshape(B, L, N_HEADS, QK_HEAD)
    return rmsnorm(q, q_norm)


def mla_keys_values(h_kv, kv_a_norm, kv_b_w, k_norm):
    B, L = h_kv.shape[:2]
    ckv, k_rope = h_kv[..., :KV_LORA], h_kv[..., KV_LORA:]
    kv = (rmsnorm(ckv, kv_a_norm) @ kv_b_w).reshape(B, L, N_HEADS, QK_NOPE + V_HEAD)
    k_nope, v = kv[..., :QK_NOPE], kv[..., QK_NOPE:]
    k_r = jnp.broadcast_to(k_rope[:, :, None, :], (B, L, N_HEADS, QK_ROPE))
    k = jnp.concatenate([k_nope, k_r], axis=-1)
    return rmsnorm(k, k_norm), v


def block_attention(q, k, v):
    B, L, H, Dh = q.shape
    nb = L // Q_BLOCK
    qb = q.reshape(B, nb, Q_BLOCK, H, Dh).transpose(1, 0, 2, 3, 4)
    scale = Dh ** -0.5

    def one_block(qi):
        s = jnp.einsum('bqhd,bkhd->bhqk', qi, k).astype(jnp.float32) * scale
        p = jax.nn.softmax(s, axis=-1)
        return jnp.einsum('bhqk,bkhv->bqhv', p.astype(v.dtype), v)

    o = lax.map(one_block, qb)
    return o.transpose(1, 0, 2, 3, 4).reshape(B, L, H * v.shape[-1])


def multiscale_pool(h, pool_w, pool_scale):
    B, L, _ = h.shape
    hf = h.astype(jnp.float32).reshape(B, L, POOL_GROUPS, POOL_GROUP)
    cs = jnp.concatenate([jnp.zeros((B, 1, POOL_GROUPS, POOL_GROUP), jnp.float32), jnp.cumsum(hf, axis=1)], axis=1)
    pos = jnp.arange(L)
    outs = []
    for gi, w in enumerate(POOL_WINDOWS):
        lo = jnp.clip(pos - w // 2, 0, L)
        hi = jnp.clip(pos + w - w // 2, 0, L)
        cnt = (hi - lo).astype(jnp.float32)[None, :, None]
        csg = cs[:, :, gi]
        window_sum = jnp.take(csg, hi, axis=1) - jnp.take(csg, lo, axis=1)
        outs.append(window_sum / cnt - hf[:, :, gi])
    pooled = jnp.stack(outs, axis=2).astype(h.dtype)
    y = jnp.einsum('blgc,gcd->blgd', pooled, pool_w).reshape(B, L, POOL_WIDTH)
    return y * pool_scale


def even_mixer(xm, xmc, update_ctx, cos, sin, w_in, q_a_norm, q_b_w, kv_a_norm, kv_b_w,
               q_norm, k_norm, pool_w, pool_scale, w_out):
    h = xm @ w_in
    h_q, h_kv, h_pool = h[..., :Q_LORA], h[..., Q_LORA:Q_LORA + KV_IN], h[..., Q_LORA + KV_IN:]
    k_c, v_c = mla_keys_values(xmc @ w_in[:, Q_LORA:Q_LORA + KV_IN], kv_a_norm, kv_b_w, k_norm)
    q = rope_heads(mla_queries(h_q, q_a_norm, q_b_w, q_norm), cos, sin)
    k, v = mla_keys_values(h_kv, kv_a_norm, kv_b_w, k_norm)
    k = rope_heads(k, cos, sin)
    attn = block_attention(q, jnp.concatenate([k_c, k], axis=1), jnp.concatenate([v_c, v], axis=1))
    y = jnp.concatenate([attn, multiscale_pool(h_pool, pool_w, pool_scale)], axis=-1) @ w_out
    y_c = None
    if update_ctx:
        q_c = mla_queries(xmc @ w_in[:, :Q_LORA], q_a_norm, q_b_w, q_norm)
        attn_c = block_attention(q_c, k_c, v_c)
        pool_c = multiscale_pool(xmc @ w_in[:, Q_LORA + KV_IN:], pool_w, pool_scale)
        y_c = jnp.concatenate([attn_c, pool_c], axis=-1) @ w_out
    return y, y_c


def short_conv_mixer(xm, w_in, conv_w, w_out):
    h = xm @ w_in
    bg, cg, hv = h[..., :D_CONV], h[..., D_CONV:2 * D_CONV], h[..., 2 * D_CONV:]
    u = cg * hv
    L = u.shape[1]
    up = jnp.pad(u, ((0, 0), (1, 1), (0, 0)))
    conv = up[:, 0:L] * conv_w[0] + up[:, 1:L + 1] * conv_w[1] + up[:, 2:L + 2] * conv_w[2]
    return (bg * conv) @ w_out


def peer_ffn(xm, wq, keys, u_tab, v_tab):
    B, L, D = xm.shape
    xt = xm.reshape(-1, PEER_CHUNK, D)
    half = PEER_D_KEY // 2
    n_cand = PEER_TOPK * PEER_TOPK

    def chunk(xc):
        q = (xc @ wq).reshape(PEER_CHUNK, PEER_HEADS, PEER_D_KEY)
        s1 = jnp.einsum('chd,hkd->chk', q[..., :half], keys[:, 0]).astype(jnp.float32)
        s2 = jnp.einsum('chd,hkd->chk', q[..., half:], keys[:, 1]).astype(jnp.float32)
        v1, i1 = lax.top_k(s1, PEER_TOPK)
        v2, i2 = lax.top_k(s2, PEER_TOPK)
        cand = (v1[..., :, None] + v2[..., None, :]).reshape(PEER_CHUNK, PEER_HEADS, n_cand)
        cid = (i1[..., :, None] * PEER_N_KEYS + i2[..., None, :]).reshape(PEER_CHUNK, PEER_HEADS, n_cand)
        top, pos = lax.top_k(cand, PEER_TOPK)
        eid = jnp.take_along_axis(cid, pos, axis=-1).reshape(PEER_CHUNK, PEER_HEADS * PEER_TOPK)
        g = jax.nn.softmax(top, axis=-1).reshape(PEER_CHUNK, PEER_HEADS * PEER_TOPK)
        u = jnp.take(u_tab, eid, axis=0)
        a = jax.nn.gelu(jnp.einsum('cd,ced->ce', xc, u), approximate=False)
        coef = (g * a.astype(jnp.float32)).astype(xc.dtype)
        return jnp.einsum('ce,ced->cd', coef, jnp.take(v_tab, eid, axis=0))

    return lax.map(chunk, xt).reshape(B, L, D)


def setup_inputs(seed: int = 0) -> dict:
    key = jax.random.key(seed)
    ks = jax.random.split(key, 26)
    D = D_MODEL

    def nrm(k, shape, std):
        return std * jax.random.normal(k, shape, jnp.float32)

    return {
        'x': nrm(ks[0], (BATCH, SEQ, D), 1.0),
        'c': nrm(ks[1], (BATCH, D), 1.0),
        'ctx': nrm(ks[2], (BATCH, CTX_LEN, D), 1.0),
        'c_ctx': nrm(ks[3], (D,), 1.0),
        'mod_w': nrm(ks[4], (DEPTH, D, 6 * D), 0.5 * D ** -0.5),
        'mod_b': nrm(ks[5], (DEPTH, 6 * D), 0.02),
        'norm_mix': 1.0 + nrm(ks[6], (DEPTH, D), 0.02),
        'norm_ffn': 1.0 + nrm(ks[7], (DEPTH, D), 0.02),
        'ab_w_in': nrm(ks[8], (N_EVEN, D, AB_IN), D ** -0.5),
        'q_a_norm': 1.0 + nrm(ks[9], (N_EVEN, Q_LORA), 0.02),
        'q_b_w': nrm(ks[10], (N_EVEN, Q_LORA, N_HEADS * QK_HEAD), Q_LORA ** -0.5),
        'kv_a_norm': 1.0 + nrm(ks[11], (N_EVEN, KV_LORA), 0.02),
        'kv_b_w': nrm(ks[12], (N_EVEN, KV_LORA, N_HEADS * (QK_NOPE + V_HEAD)), KV_LORA ** -0.5),
        'q_norm': 1.0 + nrm(ks[13], (N_EVEN, QK_HEAD), 0.02),
        'k_norm': 1.0 + nrm(ks[14], (N_EVEN, QK_HEAD), 0.02),
        'pool_w': nrm(ks[15], (N_EVEN, POOL_GROUPS, POOL_GROUP, POOL_GROUP), POOL_GROUP ** -0.5),
        'pool_scale': 1.0 + nrm(ks[16], (N_EVEN, POOL_WIDTH), 0.1),
        'ab_w_out': nrm(ks[17], (N_EVEN, MIX_OUT, D), MIX_OUT ** -0.5),
        'c_w_in': nrm(ks[18], (N_ODD, D, 3 * D_CONV), D ** -0.5),
        'c_conv': nrm(ks[19], (N_ODD, CONV_WIDTH, D_CONV), CONV_WIDTH ** -0.5),
        'c_w_out': nrm(ks[20], (N_ODD, D_CONV, D), D_CONV ** -0.5),
        'peer_wq': nrm(ks[21], (DEPTH, D, PEER_HEADS * PEER_D_KEY), D ** -0.5),
        'peer_keys': nrm(ks[22], (DEPTH, PEER_HEADS, 2, PEER_N_KEYS, PEER_D_KEY // 2), (PEER_D_KEY // 2) ** -0.5),
        'peer_u': nrm(ks[23], (DEPTH, PEER_N_EXPERTS, D), D ** -0.5),
        'peer_v': nrm(ks[24], (DEPTH, PEER_N_EXPERTS, D), 1.0),
    }


def reference(x, c, ctx, c_ctx, mod_w, mod_b, norm_mix, norm_ffn, ab_w_in, q_a_norm, q_b_w,
              kv_a_norm, kv_b_w, q_norm, k_norm, pool_w, pool_scale, ab_w_out, c_w_in, c_conv,
              c_w_out, peer_wq, peer_keys, peer_u, peer_v):
    B, L, D = x.shape
    cos, sin = axial_rope_tables(L)
    s_c = jax.nn.silu(c)
    s_cc = jax.nn.silu(c_ctx)
    ctx_s = ctx
    for i in range(DEPTH):
        even = (i % 2 == 0)
        update_ctx = any(j % 2 == 0 for j in range(i + 1, DEPTH))
        need_ctx_in = even or update_ctx
        mod = (s_c @ mod_w[i] + mod_b[i]).reshape(B, 6, D).transpose(1, 0, 2)[:, :, None, :]
        xm = modulate(rmsnorm(x, norm_mix[i]), mod[0], mod[1])
        if need_ctx_in:
            mod_c = (s_cc @ mod_w[i] + mod_b[i]).reshape(6, 1, 1, D)
            xmc = modulate(rmsnorm(ctx_s, norm_mix[i]), mod_c[0], mod_c[1])
        if even:
            e = i // 2
            y, y_c = even_mixer(xm, xmc, update_ctx, cos, sin, ab_w_in[e], q_a_norm[e], q_b_w[e],
                                kv_a_norm[e], kv_b_w[e], q_norm[e], k_norm[e], pool_w[e],
                                pool_scale[e], ab_w_out[e])
        else:
            o = i // 2
            y = short_conv_mixer(xm, c_w_in[o], c_conv[o], c_w_out[o])
            y_c = short_conv_mixer(xmc, c_w_in[o], c_conv[o], c_w_out[o]) if update_ctx else None
        x = x + mod[2] * y
        xf = modulate(rmsnorm(x, norm_ffn[i]), mod[3], mod[4])
        x = x + mod[5] * peer_ffn(xf, peer_wq[i], peer_keys[i], peer_u[i], peer_v[i])
        if update_ctx:
            ctx_s = ctx_s + mod_c[2] * y_c
            xfc = modulate(rmsnorm(ctx_s, norm_ffn[i]), mod_c[3], mod_c[4])
            ctx_s = ctx_s + mod_c[5] * peer_ffn(xfc, peer_wq[i], peer_keys[i], peer_u[i], peer_v[i])
    return x
```

```cpp
#include <hip/hip_runtime.h>
#include <stdint.h>
#include <stdio.h>
#include <hip/hip_cooperative_groups.h>
namespace cg = cooperative_groups;
#ifndef USE_CG
#define USE_CG 1
#endif

#define NTOK   32768
#define SEQ    16384
#define DM     1024
#define CTXL   256
#define MROWS  33280
#define SKEYS  16640
#define NHEAD  8
#define QKD    96
#define VD     64
#define H0LD   1280
#define NEXP   16384

typedef unsigned short bf16_t;
typedef short bf16x8 __attribute__((ext_vector_type(8)));
typedef float f32x4 __attribute__((ext_vector_type(4)));
typedef float f32x16 __attribute__((ext_vector_type(16)));
typedef unsigned u32x4 __attribute__((ext_vector_type(4)));
typedef unsigned u32x2 __attribute__((ext_vector_type(2)));

#define WS_BAR      0ull
#define WS_MODV     16384ull
#define WS_WIN_T    (WS_MODV + 147456ull)
#define WS_QB_T     (WS_WIN_T + 2621440ull)
#define WS_KVB_T    (WS_QB_T + 589824ull)
#define WS_POOL_T   (WS_KVB_T + 524288ull)
#define WS_WOUT_T   (WS_POOL_T + 131072ull)
#define WS_CIN_T    (WS_WOUT_T + 2097152ull)
#define WS_COUT_T   (WS_CIN_T + 6291456ull)
#define WS_WQ_T     (WS_COUT_T + 2097152ull)
#define WS_KEYS     (WS_WQ_T + 4194304ull)
#define WS_UTAB     (WS_KEYS + 524288ull)
#define WS_VTAB     (WS_UTAB + 67108864ull)
#define WS_A0       (WS_VTAB + 67108864ull)
#define WS_R        (WS_A0 + 68157440ull)
#define R_H0        0ull
#define R_HQN       (R_H0 + 85196800ull)
#define R_CKVN      (R_HQN + 25559040ull)
#define R_Q         (R_CKVN + 17039360ull)
#define R_K         (R_Q + 50331648ull)
#define R_VT        (R_K + 51118080ull)
#define R_END0      (R_VT + 34078720ull)
#define R_H1        0ull
#define R_Z         201326592ull
#define R_END1      (R_Z + 67108864ull)
#define WS_TOTAL    (WS_R + (R_END1 > R_END0 ? R_END1 : R_END0))


struct Params {
    const float *x, *c, *ctx, *c_ctx, *mod_w, *mod_b, *norm_mix, *norm_ffn, *ab_w_in, *q_a_norm, *q_b_w, *kv_a_norm, *kv_b_w,
                *q_norm, *k_norm, *pool_w, *pool_scale, *ab_w_out, *c_w_in, *c_conv, *c_w_out, *peer_wq, *peer_keys, *peer_u, *peer_v;
    float* out;
    unsigned char* ws;
};

typedef float f32x2 __attribute__((ext_vector_type(2)));
typedef __bf16 bf16x2_t __attribute__((ext_vector_type(2)));
__device__ __forceinline__ unsigned cvt_pk_bf16(float lo, float hi) {
    const f32x2 v = {lo, hi}; const bf16x2_t b = __builtin_convertvector(v, bf16x2_t); return __builtin_bit_cast(unsigned, b);
}
__device__ __forceinline__ float bf_lo(unsigned u) { return __uint_as_float(u << 16); }
__device__ __forceinline__ float bf_hi(unsigned u) { return __uint_as_float(u & 0xffff0000u); }
__device__ __forceinline__ float bf2f(bf16_t b) { return __uint_as_float(((unsigned)b) << 16); }
__device__ __forceinline__ float wave_sum(float v) {
#pragma unroll
    for (int o = 32; o >= 1; o >>= 1) v += __shfl_xor(v, o);
    return v;
}

#define XB_TMO      128
#define XB_XCNT(j)  (256  + 64 * (j))
#define XB_XSUB(j)  (1280 + 64 * (j))
#define XB_XGEN(j)  (2304 + 64 * (j))
#define XB_TOP      3328
#define XB_TOPGEN   3392
#define XCD_BAR_WORDS 3456
#define XB_SPIN_CAP (1u << 25)
#define LAS __attribute__((address_space(3)))

__device__ __forceinline__ unsigned xb_ld(unsigned* p)              { return __hip_atomic_load(p, __ATOMIC_RELAXED, __HIP_MEMORY_SCOPE_AGENT); }
__device__ __forceinline__ unsigned xb_add(unsigned* p, unsigned v) { return __hip_atomic_fetch_add(p, v, __ATOMIC_RELAXED, __HIP_MEMORY_SCOPE_AGENT); }
__device__ __forceinline__ unsigned xb_xcc_id() { return (unsigned)__builtin_amdgcn_s_getreg((3 << 11) | 20) & 0xFu; }
#define XB_SPIN(cond, bar) do { unsigned _sp = 0; while (cond) { __builtin_amdgcn_s_sleep(1); \
    if ((++_sp & 255u) == 0u) { if (xb_ld(&(bar)[XB_TMO])) break; if (_sp > XB_SPIN_CAP) { atomicAdd(&(bar)[XB_TMO], 1u); break; } } } } while (0)

struct XcdBarrier { unsigned* bar; unsigned x; volatile LAS unsigned* st; };

__device__ __forceinline__ XcdBarrier xcd_barrier_post(unsigned* bar, volatile LAS unsigned* st) {
    XcdBarrier b; b.bar = bar; b.x = xb_xcc_id(); b.st = st;
    if (threadIdx.x == 0) (void)xb_add(&bar[XB_XCNT(b.x)], 1u);
    return b;
}
__device__ __forceinline__ void xcd_barrier_complete(unsigned* bar, unsigned x, unsigned& nloc, unsigned& nx) {
    const unsigned G = gridDim.x * gridDim.y * gridDim.z;
    unsigned sum, cnt, mine, sp = 0u;
    for (;;) {
        sum = 0u; cnt = 0u; mine = 0u;
#pragma unroll
        for (unsigned j = 0; j < 16; ++j) { const unsigned c = xb_ld(&bar[XB_XCNT(j)]); sum += c; cnt += (c > 0u) ? 1u : 0u; mine = (j == x) ? c : mine; }
        if (sum == G) break;
        __builtin_amdgcn_s_sleep(1);
        if ((++sp & 255u) == 0u) { if (xb_ld(&bar[XB_TMO])) break; if (sp > XB_SPIN_CAP) { atomicAdd(&bar[XB_TMO], 1u); break; } }
    }
    nloc = mine > 0u ? mine : 1u; nx = cnt > 0u ? cnt : 1u;
}
__device__ __forceinline__ void xcd_barrier(const XcdBarrier& b) {
    asm volatile("s_waitcnt vmcnt(0)" ::: "memory");
    __syncthreads();
    if (threadIdx.x == 0) {
        unsigned* bar = b.bar;
        __builtin_amdgcn_s_waitcnt(0);
        unsigned nloc = b.st[0], nx = b.st[1];
        if (nloc == 0u) { xcd_barrier_complete(bar, b.x, nloc, nx); b.st[0] = nloc; b.st[1] = nx; }
        const unsigned old = xb_add(&bar[XB_XSUB(b.x)], 1u);
        const unsigned gen = old / nloc;
        if (old + 1u == (gen + 1u) * nloc) {
            __builtin_amdgcn_fence(__ATOMIC_RELEASE, "agent");
            asm volatile("s_waitcnt vmcnt(0)" ::: "memory");
            const unsigned og = xb_add(&bar[XB_TOP], 1u);
            const unsigned tg = og / nx;
            if (og + 1u == (tg + 1u) * nx) xb_add(&bar[XB_TOPGEN], 1u);
            else XB_SPIN(xb_ld(&bar[XB_TOPGEN]) == tg, bar);
            __builtin_amdgcn_fence(__ATOMIC_ACQUIRE, "agent");
            xb_add(&bar[XB_XGEN(b.x)], 1u);
            asm volatile("s_waitcnt vmcnt(0)" ::: "memory");
        } else {
            XB_SPIN(xb_ld(&bar[XB_XGEN(b.x)]) == gen, bar);
            __builtin_amdgcn_fence(__ATOMIC_ACQUIRE, "agent");
            asm volatile("s_waitcnt vmcnt(0)" ::: "memory");
        }
    }
    __syncthreads();
}

#define LDS_BYTES 75776
#define LDS_XB_OFF 75760

__device__ __forceinline__ void p0_modvec(const Params& p, float* lds_f, int task) {
    const int l = task / 96, cc = task % 96;
    const int tid = threadIdx.x, lane = tid & 63, w = tid >> 6;
    for (int i = tid; i < 3072; i += 256) {
        const int v = i >> 10, k = i & 1023;
        const float c = (v < 2) ? p.c[v * 1024 + k] : p.c_ctx[k];
        lds_f[i] = c / (1.f + __expf(-c));
    }
    __syncthreads();
    const float* W = p.mod_w + (size_t)l * 1024 * 6144 + cc * 64 + lane;
    float a0 = 0.f, a1 = 0.f, a2 = 0.f;
    const int k0 = w * 256;
#pragma unroll 8
    for (int k = 0; k < 256; ++k) {
        const float wv = W[(size_t)(k0 + k) * 6144];
        a0 += wv * lds_f[k0 + k]; a1 += wv * lds_f[1024 + k0 + k]; a2 += wv * lds_f[2048 + k0 + k];
    }
    float* red = lds_f + 3072;
    red[(w * 3 + 0) * 64 + lane] = a0; red[(w * 3 + 1) * 64 + lane] = a1; red[(w * 3 + 2) * 64 + lane] = a2;
    __syncthreads();
    if (tid < 192) {
        const int v = tid >> 6, ln = tid & 63;
        const float s = red[(0 * 3 + v) * 64 + ln] + red[(1 * 3 + v) * 64 + ln] + red[(2 * 3 + v) * 64 + ln] + red[(3 * 3 + v) * 64 + ln];
        const int col = cc * 64 + ln;
        float* modv = (float*)(p.ws + WS_MODV);
        modv[(l * 3 + v) * 6144 + col] = s + p.mod_b[l * 6144 + col];
    }
    __syncthreads();
}

struct TrD { const float* src; bf16_t* dst; int K, N; };
__device__ __forceinline__ void p0_transpose_tile(const TrD d, int tile, float* lds_f) {
    const int tilesK = d.K >> 6;
    const int tn = tile / tilesK, tk = tile % tilesK;
    const int n0 = tn * 64, k0 = tk * 64;
    const int tid = threadIdx.x;
#pragma unroll
    for (int i = 0; i < 4; ++i) {
        const int r = (tid >> 4) + 16 * i, c4 = (tid & 15) * 4;
        f32x4 v = {0.f, 0.f, 0.f, 0.f};
        if (n0 + c4 < d.N) v = *(const f32x4*)(d.src + (size_t)(k0 + r) * d.N + n0 + c4);
        float* q = lds_f + r * 65 + c4;
        q[0] = v[0]; q[1] = v[1]; q[2] = v[2]; q[3] = v[3];
    }
    __syncthreads();
    {
        const int n = tid >> 2, kc = (tid & 3) * 16;
        unsigned w[8];
#pragma unroll
        for (int j = 0; j < 8; ++j) w[j] = cvt_pk_bf16(lds_f[(kc + 2 * j) * 65 + n], lds_f[(kc + 2 * j + 1) * 65 + n]);
        bf16_t* o = d.dst + (size_t)(n0 + n) * d.K + k0 + kc;
        *(u32x4*)o = (u32x4){w[0], w[1], w[2], w[3]};
        *(u32x4*)(o + 8) = (u32x4){w[4], w[5], w[6], w[7]};
    }
    __syncthreads();
}

__device__ __forceinline__ void cvt_flat(const float* src, bf16_t* dst, size_t n) {
    const size_t nth = (size_t)gridDim.x * 256;
    for (size_t i = ((size_t)blockIdx.x * 256 + threadIdx.x) * 8; i < n; i += nth * 8) {
        const f32x4 a = *(const f32x4*)(src + i), b = *(const f32x4*)(src + i + 4);
        *(u32x4*)(dst + i) = (u32x4){cvt_pk_bf16(a[0], a[1]), cvt_pk_bf16(a[2], a[3]), cvt_pk_bf16(b[0], b[1]), cvt_pk_bf16(b[2], b[3])};
    }
}

__device__ __forceinline__ void phase0(const Params& p, unsigned char* lds) {
    float* lds_f = (float*)lds;
    for (int t = blockIdx.x; t < 192; t += gridDim.x) p0_modvec(p, lds_f, t);
    unsigned char* ws = p.ws;
#define TRANSPOSE(SRC, DSTOFF, KK, NN, NPAD) do { const TrD d_{(SRC), (bf16_t*)(ws + (DSTOFF)), (KK), (NN)}; \
        for (int t = blockIdx.x; t < ((NPAD) / 64) * ((KK) / 64); t += gridDim.x) p0_transpose_tile(d_, t, lds_f); } while (0)
    TRANSPOSE(p.ab_w_in, WS_WIN_T, 1024, 1184, 1280);
    TRANSPOSE(p.q_b_w, WS_QB_T, 384, 768, 768);
    TRANSPOSE(p.kv_b_w, WS_KVB_T, 256, 1024, 1024);
    for (int g = 0; g < 4; ++g) TRANSPOSE(p.pool_w + g * 128 * 128, WS_POOL_T + (unsigned long long)g * 128 * 128 * 2, 128, 128, 128);
    TRANSPOSE(p.ab_w_out, WS_WOUT_T, 1024, 1024, 1024);
    TRANSPOSE(p.c_w_in, WS_CIN_T, 1024, 3072, 3072);
    TRANSPOSE(p.c_w_out, WS_COUT_T, 1024, 1024, 1024);
    TRANSPOSE(p.peer_wq, WS_WQ_T, 1024, 1024, 1024);
    TRANSPOSE(p.peer_wq + 1024 * 1024, WS_WQ_T + 2097152ull, 1024, 1024, 1024);
#undef TRANSPOSE
    cvt_flat(p.peer_keys, (bf16_t*)(p.ws + WS_KEYS), 262144);
    cvt_flat(p.peer_u, (bf16_t*)(p.ws + WS_UTAB), (size_t)2 * NEXP * DM);
    cvt_flat(p.peer_v, (bf16_t*)(p.ws + WS_VTAB), (size_t)2 * NEXP * DM);
}

__device__ __forceinline__ void rowmod_phase(const Params& p, const float* src_lat, const float* src_ctx, const float* gain, int layer, int shift_idx, bf16_t* dst, int nrows) {
    const int lane = threadIdx.x & 63, w = threadIdx.x >> 6;
    const float* modv = (const float*)(p.ws + WS_MODV) + (size_t)layer * 3 * 6144;
    for (int row = blockIdx.x * 4 + w; row < nrows; row += gridDim.x * 4) {
        const float* src; int v;
        if (row < NTOK) { src = src_lat + (size_t)row * DM; v = row >> 14; }
        else { src = src_ctx + (size_t)(row - NTOK) * DM; v = 2; }
        const float* sh = modv + v * 6144 + shift_idx * 1024;
        const float* sc = sh + 1024;
        f32x4 x[4]; float ss = 0.f;
#pragma unroll
        for (int i = 0; i < 4; ++i) { x[i] = *(const f32x4*)(src + i * 256 + lane * 4); ss += x[i][0] * x[i][0] + x[i][1] * x[i][1] + x[i][2] * x[i][2] + x[i][3] * x[i][3]; }
        ss = wave_sum(ss);
        const float rstd = rsqrtf(ss * (1.0f / 1024.0f) + 1e-6f);
#pragma unroll
        for (int i = 0; i < 4; ++i) {
            const int d0 = i * 256 + lane * 4;
            const f32x4 g = *(const f32x4*)(gain + d0), s = *(const f32x4*)(sh + d0), c = *(const f32x4*)(sc + d0);
            float y[4];
#pragma unroll
            for (int j = 0; j < 4; ++j) y[j] = x[i][j] * rstd * g[j] * (1.f + c[j]) + s[j];
            *(u32x2*)(dst + (size_t)row * DM + d0) = (u32x2){cvt_pk_bf16(y[0], y[1]), cvt_pk_bf16(y[2], y[3])};
        }
    }
}

#define EPI_BF16   0
#define EPI_RESID  1
struct GemmArgs {
    const bf16_t* A; int lda;
    const bf16_t* Bt; int ldb;
    int K;
    bf16_t* C; int ldc; const float* colscale;
    const float* xin; float* xout; const float* gate; int gate_bstride;
};

__device__ __forceinline__ int swz(int row, int ch) { return row * 128 + ((ch ^ ((row >> 1) & 7)) << 4); }

template <int EPI>
__device__ __forceinline__ void gemm_tile(const GemmArgs& g, int tm, int tn, unsigned char* lds) {
    const int tid = threadIdx.x, lane = tid & 63, w = tid >> 6;
    const int wm = w >> 1, wn = w & 1;
    const int lr = lane & 15, lg = lane >> 4;
    const bf16_t* Ag = g.A + (size_t)(tm * 128) * g.lda;
    const bf16_t* Bg = g.Bt + (size_t)(tn * 128) * g.ldb;
    f32x4 acc[4][4];
#pragma unroll
    for (int i = 0; i < 4; ++i)
#pragma unroll
        for (int j = 0; j < 4; ++j) acc[i][j] = (f32x4){0.f, 0.f, 0.f, 0.f};
    u32x4 ra[4], rb[4];
    const int nk = g.K >> 6;
#pragma unroll
    for (int i = 0; i < 4; ++i) {
        const int c = tid + 256 * i, row = c >> 3, ch = c & 7;
        ra[i] = *(const u32x4*)(Ag + (size_t)row * g.lda + ch * 8);
        rb[i] = *(const u32x4*)(Bg + (size_t)row * g.ldb + ch * 8);
    }
#pragma unroll
    for (int i = 0; i < 4; ++i) {
        const int c = tid + 256 * i, row = c >> 3, ch = c & 7;
        *(u32x4*)(lds + swz(row, ch)) = ra[i];
        *(u32x4*)(lds + 16384 + swz(row, ch)) = rb[i];
    }
    __syncthreads();
    for (int kt = 0; kt < nk; ++kt) {
        const int cur = kt & 1;
        unsigned char* sAc = lds + cur * 32768; unsigned char* sBc = sAc + 16384;
        unsigned char* sAn = lds + (cur ^ 1) * 32768; unsigned char* sBn = sAn + 16384;
        if (kt + 1 < nk) {
            const int k0 = (kt + 1) * 64;
#pragma unroll
            for (int i = 0; i < 4; ++i) {
                const int c = tid + 256 * i, row = c >> 3, ch = c & 7;
                ra[i] = *(const u32x4*)(Ag + (size_t)row * g.lda + k0 + ch * 8);
                rb[i] = *(const u32x4*)(Bg + (size_t)row * g.ldb + k0 + ch * 8);
            }
        }
#pragma unroll
        for (int ks = 0; ks < 2; ++ks) {
            bf16x8 af[4], bfr[4];
#pragma unroll
            for (int i = 0; i < 4; ++i) {
                af[i]  = *(const bf16x8*)(sAc + swz(wm * 64 + i * 16 + lr, ks * 4 + lg));
                bfr[i] = *(const bf16x8*)(sBc + swz(wn * 64 + i * 16 + lr, ks * 4 + lg));
            }
#pragma unroll
            for (int i = 0; i < 4; ++i)
#pragma unroll
                for (int j = 0; j < 4; ++j) acc[i][j] = __builtin_amdgcn_mfma_f32_16x16x32_bf16(bfr[j], af[i], acc[i][j], 0, 0, 0);
        }
        if (kt + 1 < nk) {
#pragma unroll
            for (int i = 0; i < 4; ++i) {
                const int c = tid + 256 * i, row = c >> 3, ch = c & 7;
                *(u32x4*)(sAn + swz(row, ch)) = ra[i];
                *(u32x4*)(sBn + swz(row, ch)) = rb[i];
            }
        }
        __syncthreads();
    }
#pragma unroll
    for (int i = 0; i < 4; ++i) {
        const int row = tm * 128 + wm * 64 + i * 16 + lr;
#pragma unroll
        for (int j = 0; j < 4; ++j) {
            const int col = tn * 128 + wn * 64 + j * 16 + lg * 4;
            f32x4 v = acc[i][j];
            if (EPI == EPI_BF16) {
                if (g.colscale) { const f32x4 s = *(const f32x4*)(g.colscale + col); v = v * s; }
                *(u32x2*)(g.C + (size_t)row * g.ldc + col) = (u32x2){cvt_pk_bf16(v[0], v[1]), cvt_pk_bf16(v[2], v[3])};
            } else {
                const f32x4 gt = *(const f32x4*)(g.gate + (size_t)(row >> 14) * g.gate_bstride + col);
                const f32x4 xi = *(const f32x4*)(g.xin + (size_t)row * DM + col);
                *(f32x4*)(g.xout + (size_t)row * DM + col) = xi + gt * v;
            }
        }
    }
}

template <int EPI>
__device__ __forceinline__ void gemm_phase(const GemmArgs& g, int ntm, int ntn, unsigned char* lds) {
    const int nt = ntm * ntn;
    for (int t = blockIdx.x; t < nt; t += gridDim.x) gemm_tile<EPI>(g, t / ntn, t % ntn, lds);
}

__device__ __forceinline__ void latent_norm_phase(const Params& p) {
    const int lane = threadIdx.x & 63, w = threadIdx.x >> 6;
    const bf16_t* h0 = (const bf16_t*)(p.ws + WS_R + R_H0);
    bf16_t* hqn = (bf16_t*)(p.ws + WS_R + R_HQN);
    bf16_t* ckvn = (bf16_t*)(p.ws + WS_R + R_CKVN);
    for (int row = blockIdx.x * 4 + w; row < MROWS; row += gridDim.x * 4) {
        const bf16_t* hr = h0 + (size_t)row * H0LD;
        {
            const unsigned* s = (const unsigned*)(hr + lane * 6);
            const unsigned a = s[0], b = s[1], c = s[2];
            float v[6] = {bf_lo(a), bf_hi(a), bf_lo(b), bf_hi(b), bf_lo(c), bf_hi(c)};
            float ss = 0.f;
#pragma unroll
            for (int j = 0; j < 6; ++j) ss += v[j] * v[j];
            ss = wave_sum(ss);
            const float rstd = rsqrtf(ss * (1.0f / 384.0f) + 1e-6f);
            const float* gn = p.q_a_norm + lane * 6;
            unsigned* o = (unsigned*)(hqn + (size_t)row * 384 + lane * 6);
            o[0] = cvt_pk_bf16(v[0] * rstd * gn[0], v[1] * rstd * gn[1]);
            o[1] = cvt_pk_bf16(v[2] * rstd * gn[2], v[3] * rstd * gn[3]);
            o[2] = cvt_pk_bf16(v[4] * rstd * gn[4], v[5] * rstd * gn[5]);
        }
        {
            const u32x2 s = *(const u32x2*)(hr + 384 + lane * 4);
            float v[4] = {bf_lo(s[0]), bf_hi(s[0]), bf_lo(s[1]), bf_hi(s[1])};
            float ss = v[0] * v[0] + v[1] * v[1] + v[2] * v[2] + v[3] * v[3];
            ss = wave_sum(ss);
            const float rstd = rsqrtf(ss * (1.0f / 256.0f) + 1e-6f);
            const float* gn = p.kv_a_norm + lane * 4;
            *(u32x2*)(ckvn + (size_t)row * 256 + lane * 4) = (u32x2){cvt_pk_bf16(v[0] * rstd * gn[0], v[1] * rstd * gn[1]), cvt_pk_bf16(v[2] * rstd * gn[2], v[3] * rstd * gn[3])};
        }
    }
}

__device__ __forceinline__ void rope32(float* v  , int t) {
    const float inv[8] = {1.0f, 0.31622776601683794f, 0.1f, 0.031622776601683794f, 0.01f, 0.0031622776601683794f, 0.001f, 0.00031622776601683794f};
    const float pos[2] = {(float)(t >> 6), (float)(t & 63)};
#pragma unroll
    for (int a = 0; a < 2; ++a)
#pragma unroll
        for (int i = 0; i < 8; ++i) {
            const float ang = pos[a] * inv[i];
            float rev = ang * 0.15915494309189535f;
            rev = rev - floorf(rev);
            const float sn = __builtin_amdgcn_sinf(rev), cs = __builtin_amdgcn_cosf(rev);
            const float x1 = v[a * 16 + i], x2 = v[a * 16 + 8 + i];
            v[a * 16 + i] = x1 * cs - x2 * sn;
            v[a * 16 + 8 + i] = x2 * cs + x1 * sn;
        }
}

__device__ __forceinline__ void norm_rope_store(const u32x4 (&c)[12], const float* gains, bool do_rope, int t, float outscale, bf16_t* dst) {
    float ss = 0.f;
#pragma unroll
    for (int cc = 0; cc < 12; ++cc)
#pragma unroll
        for (int j = 0; j < 4; ++j) { const float lo = bf_lo(c[cc][j]), hi = bf_hi(c[cc][j]); ss += lo * lo + hi * hi; }
    const float rstd = rsqrtf(ss * (1.0f / 96.0f) + 1e-6f);
    const float rs = rstd * outscale;
#pragma unroll
    for (int cc = 0; cc < 8; ++cc) {
        u32x4 o;
#pragma unroll
        for (int j = 0; j < 4; ++j) o[j] = cvt_pk_bf16(bf_lo(c[cc][j]) * rs * gains[cc * 8 + 2 * j], bf_hi(c[cc][j]) * rs * gains[cc * 8 + 2 * j + 1]);
        *(u32x4*)(dst + cc * 8) = o;
    }
    float v[32];
#pragma unroll
    for (int cc = 0; cc < 4; ++cc)
#pragma unroll
        for (int j = 0; j < 4; ++j) { v[cc * 8 + 2 * j] = bf_lo(c[8 + cc][j]) * rstd * gains[64 + cc * 8 + 2 * j]; v[cc * 8 + 2 * j + 1] = bf_hi(c[8 + cc][j]) * rstd * gains[64 + cc * 8 + 2 * j + 1]; }
    if (do_rope) rope32(v, t);
#pragma unroll
    for (int cc = 0; cc < 4; ++cc) {
        u32x4 o;
#pragma unroll
        for (int j = 0; j < 4; ++j) o[j] = cvt_pk_bf16(v[cc * 8 + 2 * j] * outscale, v[cc * 8 + 2 * j + 1] * outscale);
        *(u32x4*)(dst + 64 + cc * 8) = o;
    }
}

__device__ __forceinline__ void qkv_post_phase(const Params& p, unsigned char* lds) {
    const int tid = threadIdx.x;
    const size_t gth = (size_t)blockIdx.x * 256 + tid, nth = (size_t)gridDim.x * 256;
    {
        bf16_t* Q = (bf16_t*)(p.ws + WS_R + R_Q);
        const float qs = 0.10206207261596575f * 1.4426950408889634f;
        for (size_t i = gth; i < (size_t)NTOK * NHEAD; i += nth) {
            const int tok = (int)(i >> 3);
            bf16_t* q = Q + i * QKD;
            u32x4 c[12];
#pragma unroll
            for (int cc = 0; cc < 12; ++cc) c[cc] = *(const u32x4*)(q + cc * 8);
            norm_rope_store(c, p.q_norm, true, tok & (SEQ - 1), qs, q);
        }
    }
    {
        const bf16_t* kv = (const bf16_t*)(p.ws + WS_A0);
        const bf16_t* h0 = (const bf16_t*)(p.ws + WS_R + R_H0);
        bf16_t* K = (bf16_t*)(p.ws + WS_R + R_K);
        for (size_t i = gth; i < (size_t)MROWS * NHEAD; i += nth) {
            const int row = (int)(i >> 3), hd = (int)(i & 7);
            int b, s, t; bool lat;
            if (row < NTOK) { b = row >> 14; t = row & (SEQ - 1); s = CTXL + t; lat = true; }
            else { const int rc = row - NTOK; b = rc >> 8; s = rc & 255; t = 0; lat = false; }
            u32x4 c[12];
            const bf16_t* kn = kv + (size_t)row * 1024 + hd * 128;
#pragma unroll
            for (int cc = 0; cc < 8; ++cc) c[cc] = *(const u32x4*)(kn + cc * 8);
            const bf16_t* kr = h0 + (size_t)row * H0LD + 640;
#pragma unroll
            for (int cc = 0; cc < 4; ++cc) c[8 + cc] = *(const u32x4*)(kr + cc * 8);
            norm_rope_store(c, p.k_norm, lat, t, 1.0f, K + ((size_t)(b * NHEAD + hd) * SKEYS + s) * QKD);
        }
    }
    {
        const bf16_t* kv = (const bf16_t*)(p.ws + WS_A0);
        bf16_t* Vt = (bf16_t*)(p.ws + WS_R + R_VT);
        bf16_t* tl = (bf16_t*)lds;
        const int ntile = 2 * NHEAD * (SKEYS / 64);
        for (int it = blockIdx.x; it < ntile; it += gridDim.x) {
            const int st = it % (SKEYS / 64), bh = it / (SKEYS / 64), b = bh >> 3, hd = bh & 7;
            const int s0 = st * 64;
            const int row0 = (s0 < CTXL) ? (NTOK + b * CTXL + s0) : (b * SEQ + s0 - CTXL);
            {
                const int key = tid >> 2, c16 = (tid & 3) * 16;
                const bf16_t* src = kv + (size_t)(row0 + key) * 1024 + hd * 128 + 64 + c16;
                const u32x4 u0 = *(const u32x4*)src, u1 = *(const u32x4*)(src + 8);
#pragma unroll
                for (int j = 0; j < 4; ++j) {
                    tl[(c16 + 2 * j) * 72 + key] = (bf16_t)(u0[j] & 0xffffu); tl[(c16 + 2 * j + 1) * 72 + key] = (bf16_t)(u0[j] >> 16);
                    tl[(c16 + 8 + 2 * j) * 72 + key] = (bf16_t)(u1[j] & 0xffffu); tl[(c16 + 8 + 2 * j + 1) * 72 + key] = (bf16_t)(u1[j] >> 16);
                }
            }
            __syncthreads();
            {
                const int dv = tid >> 2, c16 = (tid & 3) * 16;
                const u32x4 u0 = *(const u32x4*)(tl + dv * 72 + c16), u1 = *(const u32x4*)(tl + dv * 72 + c16 + 8);
                bf16_t* o = Vt + ((size_t)(bh * VD + dv)) * SKEYS + s0 + c16;
                *(u32x4*)o = u0; *(u32x4*)(o + 8) = u1;
            }
            __syncthreads();
        }
    }
    {
        const bf16_t* h0 = (const bf16_t*)(p.ws + WS_R + R_H0);
        bf16_t* pooled = (bf16_t*)(p.ws + WS_R + R_HQN);
        for (size_t i = gth; i < (size_t)NTOK * 64; i += nth) {
            const int tok = (int)(i >> 6), ch = (int)(i & 63);
            const int b = tok >> 14, t = tok & (SEQ - 1);
            const int grp = ch >> 4, wdw = 2 << grp;
            int lo = t - (wdw >> 1), hi = t + (wdw >> 1);
            lo = lo < 0 ? 0 : lo; hi = hi > SEQ ? SEQ : hi;
            float sum[8] = {0.f, 0.f, 0.f, 0.f, 0.f, 0.f, 0.f, 0.f}, self[8];
            const bf16_t* base = h0 + (size_t)(b * SEQ) * H0LD + 672 + ch * 8;
            for (int tt = lo; tt < hi; ++tt) {
                const u32x4 u = *(const u32x4*)(base + (size_t)tt * H0LD);
#pragma unroll
                for (int j = 0; j < 4; ++j) { sum[2 * j] += bf_lo(u[j]); sum[2 * j + 1] += bf_hi(u[j]); }
                if (tt == t) {
#pragma unroll
                    for (int j = 0; j < 4; ++j) { self[2 * j] = bf_lo(u[j]); self[2 * j + 1] = bf_hi(u[j]); }
                }
            }
            const float rc = 1.0f / (float)(hi - lo);
            u32x4 o;
#pragma unroll
            for (int j = 0; j < 4; ++j) o[j] = cvt_pk_bf16(sum[2 * j] * rc - self[2 * j], sum[2 * j + 1] * rc - self[2 * j + 1]);
            *(u32x4*)(pooled + (size_t)tok * 512 + ch * 8) = o;
        }
    }
}

#define AT_KROW 208
#define AT_VROW 144
#define AT_KBUF (64 * AT_KROW)
#define AT_VBUF (64 * AT_VROW)
__device__ __forceinline__ void attention_item(const Params& p, int bh, int qblk, unsigned char* lds) {
    const int tid = threadIdx.x, lane = tid & 63, w = tid >> 6;
    const int r = lane & 31, hh = lane >> 5;
    const int b = bh >> 3, hd = bh & 7;
    const bf16_t* Q = (const bf16_t*)(p.ws + WS_R + R_Q);
    const bf16_t* Kg = (const bf16_t*)(p.ws + WS_R + R_K) + (size_t)bh * SKEYS * QKD;
    const bf16_t* Vg = (const bf16_t*)(p.ws + WS_R + R_VT) + (size_t)bh * VD * SKEYS;
    bf16_t* outc = (bf16_t*)(p.ws + WS_R + R_H0);

    const int tok = b * SEQ + qblk * 128 + w * 32 + r;
    bf16x8 qf[6];
#pragma unroll
    for (int ds = 0; ds < 6; ++ds) qf[ds] = *(const bf16x8*)(Q + ((size_t)tok * NHEAD + hd) * QKD + ds * 16 + hh * 8);

    f32x16 O0, O1;
#pragma unroll
    for (int i = 0; i < 16; ++i) { O0[i] = 0.f; O1[i] = 0.f; }
    float lsum = 0.f;

    u32x4 rk[3], rv[2];
    auto load_tile = [&](int kt) {
        const bf16_t* kg = Kg + (size_t)kt * 64 * QKD;
#pragma unroll
        for (int i = 0; i < 3; ++i) rk[i] = *(const u32x4*)(kg + (size_t)(tid + 256 * i) * 8);
#pragma unroll
        for (int i = 0; i < 2; ++i) { const int c = tid + 256 * i, dv = c >> 3, ch = c & 7; rv[i] = *(const u32x4*)(Vg + (size_t)dv * SKEYS + kt * 64 + ch * 8); }
    };
    auto store_tile = [&](int buf) {
        unsigned char* sKb = lds + buf * (AT_KBUF + AT_VBUF); unsigned char* sVb = sKb + AT_KBUF;
#pragma unroll
        for (int i = 0; i < 3; ++i) { const int c = tid + 256 * i, row = c / 12, ch = c % 12; *(u32x4*)(sKb + row * AT_KROW + ch * 16) = rk[i]; }
#pragma unroll
        for (int i = 0; i < 2; ++i) { const int c = tid + 256 * i, dv = c >> 3, ch = c & 7; *(u32x4*)(sVb + dv * AT_VROW + ch * 16) = rv[i]; }
    };
    const int krow = (r & 0x13) | ((r & 4) << 1) | ((r & 8) >> 1);
    const int NT = SKEYS / 64;
    __syncthreads();
    load_tile(0); store_tile(0);
    __syncthreads();
    for (int kt = 0; kt < NT; ++kt) {
        const int cur = kt & 1;
        const unsigned char* sKc = lds + cur * (AT_KBUF + AT_VBUF); const unsigned char* sVc = sKc + AT_KBUF;
        if (kt + 1 < NT) load_tile(kt + 1);
#pragma unroll
        for (int sub = 0; sub < 2; ++sub) {
            f32x16 S;
#pragma unroll
            for (int i = 0; i < 16; ++i) S[i] = 0.f;
            const unsigned char* kb = sKc + (sub * 32 + krow) * AT_KROW + hh * 16;
#pragma unroll
            for (int ds = 0; ds < 6; ++ds) {
                const bf16x8 kf = *(const bf16x8*)(kb + ds * 32);
                S = __builtin_amdgcn_mfma_f32_32x32x16_bf16(kf, qf[ds], S, 0, 0, 0);
            }
            float ps = 0.f;
#pragma unroll
            for (int i = 0; i < 16; ++i) { S[i] = __builtin_amdgcn_exp2f(S[i]); ps += S[i]; }
            lsum += ps;
            bf16x8 pb[2];
#pragma unroll
            for (int s = 0; s < 2; ++s) {
                u32x4 u;
#pragma unroll
                for (int j = 0; j < 4; ++j) u[j] = cvt_pk_bf16(S[8 * s + 2 * j], S[8 * s + 2 * j + 1]);
                pb[s] = *(bf16x8*)&u;
            }
            const unsigned char* vb = sVc + r * AT_VROW + (sub * 32 + hh * 8) * 2;
#pragma unroll
            for (int s = 0; s < 2; ++s) {
                const bf16x8 v0 = *(const bf16x8*)(vb + s * 32);
                const bf16x8 v1 = *(const bf16x8*)(vb + 32 * AT_VROW + s * 32);
                O0 = __builtin_amdgcn_mfma_f32_32x32x16_bf16(v0, pb[s], O0, 0, 0, 0);
                O1 = __builtin_amdgcn_mfma_f32_32x32x16_bf16(v1, pb[s], O1, 0, 0, 0);
            }
        }
        if (kt + 1 < NT) store_tile(cur ^ 1);
        __syncthreads();
    }
    lsum += __shfl_xor(lsum, 32);
    const float rl = 1.0f / lsum;
    bf16_t* o = outc + (size_t)tok * 1024 + hd * 64;
#pragma unroll
    for (int g4 = 0; g4 < 4; ++g4) {
        *(u32x2*)(o + 8 * g4 + 4 * hh) = (u32x2){cvt_pk_bf16(O0[4 * g4] * rl, O0[4 * g4 + 1] * rl), cvt_pk_bf16(O0[4 * g4 + 2] * rl, O0[4 * g4 + 3] * rl)};
        *(u32x2*)(o + 32 + 8 * g4 + 4 * hh) = (u32x2){cvt_pk_bf16(O1[4 * g4] * rl, O1[4 * g4 + 1] * rl), cvt_pk_bf16(O1[4 * g4 + 2] * rl, O1[4 * g4 + 3] * rl)};
    }
}

__device__ __forceinline__ void attention_phase(const Params& p, unsigned char* lds) {
    for (int it = blockIdx.x; it < 2048; it += gridDim.x) {
        const int xcd = it & 7, j = it >> 3;
        attention_item(p, xcd * 2 + (j >> 7), j & 127, lds);
    }
}

__device__ __forceinline__ void conv_phase(const Params& p) {
    const bf16_t* h1 = (const bf16_t*)(p.ws + WS_R + R_H1);
    bf16_t* z = (bf16_t*)(p.ws + WS_R + R_Z);
    const size_t gth = (size_t)blockIdx.x * 256 + threadIdx.x, nth = (size_t)gridDim.x * 256;
    for (size_t i = gth; i < (size_t)NTOK * 128; i += nth) {
        const int tok = (int)(i >> 7), ch = (int)(i & 127) * 8;
        const int t = tok & (SEQ - 1);
        const bf16_t* hr = h1 + (size_t)tok * 3072 + ch;
        float acc[8] = {0.f, 0.f, 0.f, 0.f, 0.f, 0.f, 0.f, 0.f};
#pragma unroll
        for (int d = -1; d <= 1; ++d) {
            if (t + d < 0 || t + d >= SEQ) continue;
            const u32x4 cg = *(const u32x4*)(hr + (ptrdiff_t)d * 3072 + 1024), hv = *(const u32x4*)(hr + (ptrdiff_t)d * 3072 + 2048);
            const float* cw = p.c_conv + (d + 1) * 1024 + ch;
            const f32x4 w0 = *(const f32x4*)cw, w1 = *(const f32x4*)(cw + 4);
#pragma unroll
            for (int j = 0; j < 4; ++j) {
                const float wa = (j < 2) ? w0[2 * j] : w1[2 * j - 4], wb = (j < 2) ? w0[2 * j + 1] : w1[2 * j - 3];
                acc[2 * j] += bf_lo(cg[j]) * bf_lo(hv[j]) * wa;
                acc[2 * j + 1] += bf_hi(cg[j]) * bf_hi(hv[j]) * wb;
            }
        }
        const u32x4 bg = *(const u32x4*)hr;
        u32x4 o;
#pragma unroll
        for (int j = 0; j < 4; ++j) o[j] = cvt_pk_bf16(bf_lo(bg[j]) * acc[2 * j], bf_hi(bg[j]) * acc[2 * j + 1]);
        *(u32x4*)(z + (size_t)tok * 1024 + ch) = o;
    }
}

#define TK_LD 260
__device__ __forceinline__ void tk_insert(float (&top)[16], float x) {
#pragma unroll
    for (int j = 0; j < 16; ++j) { const float t = fmaxf(top[j], x); x = fminf(top[j], x); top[j] = t; }
}
__device__ __forceinline__ void peer_topk_phase(const Params& p, int layer, const bf16_t* qp, int* eid, float* gw, unsigned char* lds) {
    const int tid = threadIdx.x, lane = tid & 63, w = tid >> 6;
    const int lr = lane & 15, lg = lane >> 4;
    float* sc = (float*)lds;
    float* lst = (float*)(lds + 64 * TK_LD * 4);
    const bf16_t* keys = (const bf16_t*)(p.ws + WS_KEYS) + (size_t)layer * 8 * 2 * 128 * 64;
    for (int it = blockIdx.x; it < 512 * 8; it += gridDim.x) {
        const int hd = it & 7, tt = it >> 3, tok0 = tt * 64;
        {
            const int side = w >> 1, half = w & 1;
            f32x4 acc[4][4];
#pragma unroll
            for (int i = 0; i < 4; ++i)
#pragma unroll
                for (int j = 0; j < 4; ++j) acc[i][j] = (f32x4){0.f, 0.f, 0.f, 0.f};
            const bf16_t* qa = qp + (size_t)(tok0 + lr) * 1024 + hd * 128 + side * 64 + lg * 8;
            const bf16_t* kb = keys + ((size_t)(hd * 2 + side) * 128 + half * 64 + lr) * 64 + lg * 8;
#pragma unroll
            for (int ks = 0; ks < 2; ++ks) {
                bf16x8 af[4], bfr[4];
#pragma unroll
                for (int i = 0; i < 4; ++i) { af[i] = *(const bf16x8*)(qa + (size_t)i * 16 * 1024 + ks * 32); bfr[i] = *(const bf16x8*)(kb + i * 16 * 64 + ks * 32); }
#pragma unroll
                for (int i = 0; i < 4; ++i)
#pragma unroll
                    for (int j = 0; j < 4; ++j) acc[i][j] = __builtin_amdgcn_mfma_f32_16x16x32_bf16(af[i], bfr[j], acc[i][j], 0, 0, 0);
            }
#pragma unroll
            for (int i = 0; i < 4; ++i)
#pragma unroll
                for (int j = 0; j < 4; ++j)
#pragma unroll
                    for (int jj = 0; jj < 4; ++jj) sc[(i * 16 + lg * 4 + jj) * TK_LD + side * 128 + half * 64 + j * 16 + lr] = acc[i][j][jj];
        }
        __syncthreads();
        if (tid < 128) {
            const int token = tid & 63, side = tid >> 6;
            float top[16];
#pragma unroll
            for (int j = 0; j < 16; ++j) top[j] = -3.0e38f;
            const float* s = sc + token * TK_LD + side * 128;
            for (int k4 = 0; k4 < 32; ++k4) {
                const f32x4 v = *(const f32x4*)(s + k4 * 4);
#pragma unroll
                for (int e = 0; e < 4; ++e) tk_insert(top, __uint_as_float((__float_as_uint(v[e]) & ~127u) | (unsigned)(k4 * 4 + e)));
            }
#pragma unroll
            for (int j = 0; j < 16; ++j) lst[(token * 2 + side) * 16 + j] = top[j];
        }
        __syncthreads();
        if (tid < 64) {
            const int token = tid;
            float v1[16], v2[16], top[16];
#pragma unroll
            for (int j = 0; j < 16; ++j) { v1[j] = lst[(token * 2) * 16 + j]; v2[j] = lst[(token * 2 + 1) * 16 + j]; top[j] = -3.0e38f; }
#pragma unroll
            for (int i = 0; i < 16; ++i)
#pragma unroll
                for (int j = 0; j < 16; ++j)
                    if ((i + 1) * (j + 1) <= 16) {
                        const float a = __uint_as_float(__float_as_uint(v1[i]) & ~127u), bb = __uint_as_float(__float_as_uint(v2[j]) & ~127u);
                        tk_insert(top, __uint_as_float((__float_as_uint(a + bb) & ~255u) | (unsigned)(i * 16 + j)));
                    }
            const float m = top[0];
            float e[16], sum = 0.f;
#pragma unroll
            for (int j = 0; j < 16; ++j) { e[j] = __expf(top[j] - m); sum += e[j]; }
            const float rs = 1.0f / sum;
            int* eo = eid + (size_t)(tok0 + token) * 128 + hd * 16;
            float* go = gw + (size_t)(tok0 + token) * 128 + hd * 16;
#pragma unroll
            for (int j = 0; j < 16; ++j) {
                const unsigned pl = __float_as_uint(top[j]) & 255u;
                const unsigned i1 = __float_as_uint(lst[(token * 2) * 16 + (pl >> 4)]) & 127u;
                const unsigned i2 = __float_as_uint(lst[(token * 2 + 1) * 16 + (pl & 15u)]) & 127u;
                eo[j] = (int)(i1 * 128u + i2);
                go[j] = e[j] * rs;
            }
        }
        __syncthreads();
    }
}

__device__ __forceinline__ void peer_gather_phase(const Params& p, int layer, const bf16_t* xf, const int* eid, const float* gw, float* xio, unsigned char* lds) {
    const int tid = threadIdx.x, lane = tid & 63, w = tid >> 6;
    const int lr = lane & 15, lg = lane >> 4;
    unsigned char* xs = lds + w * 4096;
    float* coefs = (float*)(xs + 2048);
    const bf16_t* U = (const bf16_t*)(p.ws + WS_UTAB) + (size_t)layer * NEXP * DM;
    const bf16_t* V = (const bf16_t*)(p.ws + WS_VTAB) + (size_t)layer * NEXP * DM;
    const float* modv = (const float*)(p.ws + WS_MODV) + (size_t)layer * 3 * 6144;
    for (int tok = blockIdx.x * 4 + w; tok < NTOK; tok += gridDim.x * 4) {
        {
            const u32x4 a = *(const u32x4*)(xf + (size_t)tok * DM + lane * 8), bq = *(const u32x4*)(xf + (size_t)tok * DM + 512 + lane * 8);
            *(u32x4*)(xs + lane * 16) = a; *(u32x4*)(xs + 1024 + lane * 16) = bq;
        }
        const int e_lo = eid[(size_t)tok * 128 + lane], e_hi = eid[(size_t)tok * 128 + 64 + lane];
        const float g_lo = gw[(size_t)tok * 128 + lane], g_hi = gw[(size_t)tok * 128 + 64 + lane];
        __builtin_amdgcn_wave_barrier();
        asm volatile("s_waitcnt lgkmcnt(0)" ::: "memory");
#pragma unroll 1
        for (int blk = 0; blk < 8; ++blk) {
            const int src = (blk * 16 + lr) & 63;
            const int e = __shfl((blk < 4) ? e_lo : e_hi, src);
            const float gg = __shfl((blk < 4) ? g_lo : g_hi, src);
            const bf16_t* ur = U + (size_t)e * DM + lg * 8;
            f32x4 acc = {0.f, 0.f, 0.f, 0.f};
#pragma unroll
            for (int ks = 0; ks < 32; ++ks) {
                const bf16x8 bfr = *(const bf16x8*)(ur + ks * 32);
                const bf16x8 af = *(const bf16x8*)(xs + ks * 64 + lg * 16);
                acc = __builtin_amdgcn_mfma_f32_16x16x32_bf16(af, bfr, acc, 0, 0, 0);
            }
            const float a = acc[0];
            const float ge = 0.5f * a * (1.0f + erff(a * 0.70710678118654752f));
            if (lane < 16) coefs[blk * 16 + lane] = gg * ge;
        }
        __builtin_amdgcn_wave_barrier();
        asm volatile("s_waitcnt lgkmcnt(0)" ::: "memory");
        float o[16];
#pragma unroll
        for (int j = 0; j < 16; ++j) o[j] = 0.f;
#pragma unroll 1
        for (int half = 0; half < 2; ++half) {
            const int ev = half ? e_hi : e_lo;
#pragma unroll 8
            for (int i = 0; i < 64; ++i) {
                const int e = __builtin_amdgcn_readlane(ev, i);
                const float cf = coefs[half * 64 + i];
                const bf16_t* vr = V + (size_t)e * DM + lane * 8;
                const u32x4 a = *(const u32x4*)vr, bq = *(const u32x4*)(vr + 512);
#pragma unroll
                for (int j = 0; j < 4; ++j) {
                    o[2 * j] += cf * bf_lo(a[j]); o[2 * j + 1] += cf * bf_hi(a[j]);
                    o[8 + 2 * j] += cf * bf_lo(bq[j]); o[8 + 2 * j + 1] += cf * bf_hi(bq[j]);
                }
            }
        }
        const float* gate = modv + (tok >> 14) * 6144 + 5 * 1024;
        float* xr = xio + (size_t)tok * DM;
#pragma unroll
        for (int h2 = 0; h2 < 2; ++h2)
#pragma unroll
            for (int q4 = 0; q4 < 2; ++q4) {
                const int d0 = h2 * 512 + lane * 8 + q4 * 4;
                const f32x4 gt = *(const f32x4*)(gate + d0);
                f32x4 xv = *(const f32x4*)(xr + d0);
#pragma unroll
                for (int j = 0; j < 4; ++j) xv[j] += gt[j] * o[h2 * 8 + q4 * 4 + j];
                *(f32x4*)(xr + d0) = xv;
            }
        __builtin_amdgcn_wave_barrier();
    }
}

#ifndef STOP_PHASE
#define STOP_PHASE 1000
#endif
#if USE_CG
#define PHASE_END(n) do { cg::this_grid().sync(); if (STOP_PHASE == (n)) return; } while (0)
#else
#define PHASE_END(n) do { xcd_barrier(xb); if (STOP_PHASE == (n)) return; } while (0)
#endif

__global__ void __launch_bounds__(256, 2) fwd_megakernel(Params p) {
    __shared__ __attribute__((aligned(16))) unsigned char lds[LDS_BYTES];
    if (threadIdx.x == 0) { *(u32x4*)(lds + LDS_XB_OFF) = (u32x4){0u, 0u, 0u, 0u}; }
    __syncthreads();
    XcdBarrier xb = xcd_barrier_post((unsigned*)(p.ws + WS_BAR), (volatile LAS unsigned*)(lds + LDS_XB_OFF));
    unsigned char* ws = p.ws;
    const float* modv = (const float*)(ws + WS_MODV);
    bf16_t* A0 = (bf16_t*)(ws + WS_A0);

    phase0(p, lds);
    PHASE_END(0);
    rowmod_phase(p, p.x, p.ctx, p.norm_mix, 0, 0, A0, MROWS);
    PHASE_END(1);
    {
        GemmArgs g{}; g.A = A0; g.lda = 1024; g.Bt = (const bf16_t*)(ws + WS_WIN_T); g.ldb = 1024; g.K = 1024;
        g.C = (bf16_t*)(ws + WS_R + R_H0); g.ldc = H0LD; g.colscale = nullptr;
        gemm_phase<EPI_BF16>(g, MROWS / 128, H0LD / 128, lds);
    }
    PHASE_END(2);
    latent_norm_phase(p);
    PHASE_END(3);
    {
        GemmArgs g{}; g.A = (const bf16_t*)(ws + WS_R + R_HQN); g.lda = 384; g.Bt = (const bf16_t*)(ws + WS_QB_T); g.ldb = 384; g.K = 384;
        g.C = (bf16_t*)(ws + WS_R + R_Q); g.ldc = 768; g.colscale = nullptr;
        GemmArgs g2{}; g2.A = (const bf16_t*)(ws + WS_R + R_CKVN); g2.lda = 256; g2.Bt = (const bf16_t*)(ws + WS_KVB_T); g2.ldb = 256; g2.K = 256;
        g2.C = A0; g2.ldc = 1024; g2.colscale = nullptr;
        const int n1 = (NTOK / 128) * 6, n2 = (MROWS / 128) * 8;
        for (int t = blockIdx.x; t < n1 + n2; t += gridDim.x) {
            if (t < n1) gemm_tile<EPI_BF16>(g, t / 6, t % 6, lds);
            else { const int u = t - n1; gemm_tile<EPI_BF16>(g2, u / 8, u % 8, lds); }
        }
    }
    PHASE_END(4);
    qkv_post_phase(p, lds);
    PHASE_END(5);
    {
        for (int t = blockIdx.x; t < 4 * (NTOK / 128); t += gridDim.x) {
            const int grp = t & 3, tm = t >> 2;
            GemmArgs g{}; g.A = (const bf16_t*)(ws + WS_R + R_HQN) + grp * 128; g.lda = 512; g.Bt = (const bf16_t*)(ws + WS_POOL_T) + grp * 128 * 128; g.ldb = 128; g.K = 128;
            g.C = (bf16_t*)(ws + WS_R + R_H0) + 512 + grp * 128; g.ldc = 1024; g.colscale = p.pool_scale + grp * 128;
            gemm_tile<EPI_BF16>(g, tm, 0, lds);
        }
    }
    PHASE_END(6);
    attention_phase(p, lds);
    PHASE_END(7);
    {
        GemmArgs g{}; g.A = (const bf16_t*)(ws + WS_R + R_H0); g.lda = 1024; g.Bt = (const bf16_t*)(ws + WS_WOUT_T); g.ldb = 1024; g.K = 1024;
        g.xin = p.x; g.xout = p.out; g.gate = modv + 2 * 1024; g.gate_bstride = 6144;
        gemm_phase<EPI_RESID>(g, NTOK / 128, 8, lds);
    }
    PHASE_END(8);
    rowmod_phase(p, p.out, p.ctx, p.norm_ffn, 0, 3, A0, NTOK);
    PHASE_END(9);
    {
        GemmArgs g{}; g.A = A0; g.lda = 1024; g.Bt = (const bf16_t*)(ws + WS_WQ_T); g.ldb = 1024; g.K = 1024;
        g.C = (bf16_t*)(ws + WS_R + R_Q); g.ldc = 1024; g.colscale = nullptr;
        gemm_phase<EPI_BF16>(g, NTOK / 128, 8, lds);
    }
    PHASE_END(10);
    peer_topk_phase(p, 0, (const bf16_t*)(ws + WS_R + R_Q), (int*)(ws + WS_R + R_VT), (float*)(ws + WS_R + R_VT + 16777216ull), lds);
    PHASE_END(11);
    peer_gather_phase(p, 0, A0, (const int*)(ws + WS_R + R_VT), (const float*)(ws + WS_R + R_VT + 16777216ull), p.out, lds);
    PHASE_END(12);
    rowmod_phase(p, p.out, p.ctx, p.norm_mix + 1024, 1, 0, A0, NTOK);
    PHASE_END(13);
    {
        GemmArgs g{}; g.A = A0; g.lda = 1024; g.Bt = (const bf16_t*)(ws + WS_CIN_T); g.ldb = 1024; g.K = 1024;
        g.C = (bf16_t*)(ws + WS_R + R_H1); g.ldc = 3072; g.colscale = nullptr;
        gemm_phase<EPI_BF16>(g, NTOK / 128, 24, lds);
    }
    PHASE_END(14);
    conv_phase(p);
    PHASE_END(15);
    {
        GemmArgs g{}; g.A = (const bf16_t*)(ws + WS_R + R_Z); g.lda = 1024; g.Bt = (const bf16_t*)(ws + WS_COUT_T); g.ldb = 1024; g.K = 1024;
        g.xin = p.out; g.xout = p.out; g.gate = modv + 3 * 6144 + 2 * 1024; g.gate_bstride = 6144;
        gemm_phase<EPI_RESID>(g, NTOK / 128, 8, lds);
    }
    PHASE_END(16);
    rowmod_phase(p, p.out, p.ctx, p.norm_ffn + 1024, 1, 3, A0, NTOK);
    PHASE_END(17);
    {
        GemmArgs g{}; g.A = A0; g.lda = 1024; g.Bt = (const bf16_t*)(ws + WS_WQ_T) + 1024 * 1024; g.ldb = 1024; g.K = 1024;
        g.C = (bf16_t*)(ws + WS_R + R_H1); g.ldc = 1024; g.colscale = nullptr;
        gemm_phase<EPI_BF16>(g, NTOK / 128, 8, lds);
    }
    PHASE_END(18);
    peer_topk_phase(p, 1, (const bf16_t*)(ws + WS_R + R_H1), (int*)(ws + WS_R + 67108864ull), (float*)(ws + WS_R + 67108864ull + 16777216ull), lds);
    PHASE_END(19);
    peer_gather_phase(p, 1, A0, (const int*)(ws + WS_R + 67108864ull), (const float*)(ws + WS_R + 67108864ull + 16777216ull), p.out, lds);
}

extern "C" void kernel_launch(void* const* d_in, const int* in_sizes, int n_in, void* d_out, int out_size, void* d_ws, size_t ws_size, hipStream_t stream) {
    static int grid = 0;
    if (grid == 0) {
        if (n_in != 25 || out_size != NTOK * DM || ws_size < WS_TOTAL) {
            fprintf(stderr, "kernel_launch: unexpected sizes (n_in %d, out %d, ws %zu, need %llu)\n", n_in, out_size, ws_size, (unsigned long long)WS_TOTAL);
            grid = -1; return;
        }
        int dev = 0, cus = 0, per_cu = 0;
        (void)hipGetDevice(&dev);
        (void)hipDeviceGetAttribute(&cus, hipDeviceAttributeMultiprocessorCount, dev);
        if (hipOccupancyMaxActiveBlocksPerMultiprocessor(&per_cu, (const void*)fwd_megakernel, 256, 0) != hipSuccess || per_cu < 1) { fprintf(stderr, "kernel_launch: occupancy query failed\n"); grid = -1; return; }
        if (per_cu > 2) per_cu = 2;
        grid = cus * per_cu;
    }
    if (grid < 0) return;
    Params p{};
    const float** f = (const float**)&p.x;
    for (int i = 0; i < 25; ++i) f[i] = (const float*)d_in[i];
    p.out = (float*)d_out; p.ws = (unsigned char*)d_ws;
    (void)hipMemsetAsync(d_ws, 0, XCD_BAR_WORDS * 4, stream);
#if USE_CG
    void* args[] = {&p};
    hipError_t e = hipLaunchCooperativeKernel((const void*)fwd_megakernel, dim3(grid), dim3(256), args, 0, stream);
    if (e != hipSuccess) fprintf(stderr, "cooperative launch failed: %s (grid %d)\n", hipGetErrorString(e), grid);
#else
    hipLaunchKernelGGL(fwd_megakernel, dim3(grid), dim3(256), 0, stream, p);
#endif
}
```

```cpp
#include <hip/hip_runtime.h>
#include <stdint.h>
#include <stdio.h>
#include <hip/hip_cooperative_groups.h>
namespace cg = cooperative_groups;
#ifndef USE_CG
#define USE_CG 0
#endif

#define NTOK   32768
#define SEQ    16384
#define DM     1024
#define CTXL   256
#define MROWS  33280
#define SKEYS  16640
#define NHEAD  8
#define QKD    96
#define VD     64
#define H0LD   1280
#define NEXP   16384

typedef unsigned short bf16_t;
typedef short bf16x8 __attribute__((ext_vector_type(8)));
typedef float f32x4 __attribute__((ext_vector_type(4)));
typedef float f32x16 __attribute__((ext_vector_type(16)));
typedef unsigned u32x4 __attribute__((ext_vector_type(4)));
typedef unsigned u32x2 __attribute__((ext_vector_type(2)));

#define WS_BAR      0ull
#define WS_MODV     16384ull
#define WS_WIN_T    (WS_MODV + 147456ull)
#define WS_QB_T     (WS_WIN_T + 2621440ull)
#define WS_KVB_T    (WS_QB_T + 589824ull)
#define WS_POOL_T   (WS_KVB_T + 524288ull)
#define WS_WOUT_T   (WS_POOL_T + 131072ull)
#define WS_CIN_T    (WS_WOUT_T + 2097152ull)
#define WS_COUT_T   (WS_CIN_T + 6291456ull)
#define WS_WQ_T     (WS_COUT_T + 2097152ull)
#define WS_KEYS     (WS_WQ_T + 4194304ull)
#define WS_UTAB     (WS_KEYS + 524288ull)
#define WS_VTAB     (WS_UTAB + 67108864ull)
#define WS_A0       (WS_VTAB + 67108864ull)
#define WS_R        (WS_A0 + 68157440ull)
#define R_H0        0ull
#define R_HQN       (R_H0 + 85196800ull)
#define R_CKVN      (R_HQN + 25559040ull)
#define R_Q         (R_CKVN + 17039360ull)
#define R_K         (R_Q + 50331648ull)
#define R_VT        (R_K + 51118080ull)
#define R_END0      (R_VT + 34078720ull)
#define R_H1        0ull
#define R_Z         201326592ull
#define R_END1      (R_Z + 67108864ull)
#define WS_TOTAL    (WS_R + (R_END1 > R_END0 ? R_END1 : R_END0))


struct Params {
    const float *x, *c, *ctx, *c_ctx, *mod_w, *mod_b, *norm_mix, *norm_ffn, *ab_w_in, *q_a_norm, *q_b_w, *kv_a_norm, *kv_b_w,
                *q_norm, *k_norm, *pool_w, *pool_scale, *ab_w_out, *c_w_in, *c_conv, *c_w_out, *peer_wq, *peer_keys, *peer_u, *peer_v;
    float* out;
    unsigned char* ws;
};

typedef float f32x2 __attribute__((ext_vector_type(2)));
typedef __bf16 bf16x2_t __attribute__((ext_vector_type(2)));
__device__ __forceinline__ unsigned cvt_pk_bf16(float lo, float hi) {
    const f32x2 v = {lo, hi}; const bf16x2_t b = __builtin_convertvector(v, bf16x2_t); return __builtin_bit_cast(unsigned, b);
}
__device__ __forceinline__ float bf_lo(unsigned u) { return __uint_as_float(u << 16); }
__device__ __forceinline__ float bf_hi(unsigned u) { return __uint_as_float(u & 0xffff0000u); }
__device__ __forceinline__ float bf2f(bf16_t b) { return __uint_as_float(((unsigned)b) << 16); }
__device__ __forceinline__ float wave_sum(float v) {
#pragma unroll
    for (int o = 32; o >= 1; o >>= 1) v += __shfl_xor(v, o);
    return v;
}

#define XB_TMO      128
#define XB_XCNT(j)  (256  + 64 * (j))
#define XB_XSUB(j)  (1280 + 64 * (j))
#define XB_XGEN(j)  (2304 + 64 * (j))
#define XB_TOP      3328
#define XB_TOPGEN   3392
#define XCD_BAR_WORDS 3456
#define XB_SPIN_CAP (1u << 25)
#define LAS __attribute__((address_space(3)))

__device__ __forceinline__ unsigned xb_ld(unsigned* p)              { return __hip_atomic_load(p, __ATOMIC_RELAXED, __HIP_MEMORY_SCOPE_AGENT); }
__device__ __forceinline__ unsigned xb_add(unsigned* p, unsigned v) { return __hip_atomic_fetch_add(p, v, __ATOMIC_RELAXED, __HIP_MEMORY_SCOPE_AGENT); }
__device__ __forceinline__ unsigned xb_xcc_id() { return (unsigned)__builtin_amdgcn_s_getreg((3 << 11) | 20) & 0xFu; }
#define XB_SPIN(cond, bar) do { unsigned _sp = 0; while (cond) { __builtin_amdgcn_s_sleep(1); \
    if ((++_sp & 255u) == 0u) { if (xb_ld(&(bar)[XB_TMO])) break; if (_sp > XB_SPIN_CAP) { atomicAdd(&(bar)[XB_TMO], 1u); break; } } } } while (0)

struct XcdBarrier { unsigned* bar; unsigned x; volatile LAS unsigned* st; };

__device__ __forceinline__ XcdBarrier xcd_barrier_post(unsigned* bar, volatile LAS unsigned* st) {
    XcdBarrier b; b.bar = bar; b.x = xb_xcc_id(); b.st = st;
    if (threadIdx.x == 0) (void)xb_add(&bar[XB_XCNT(b.x)], 1u);
    return b;
}
__device__ __forceinline__ void xcd_barrier_complete(unsigned* bar, unsigned x, unsigned& nloc, unsigned& nx) {
    const unsigned G = gridDim.x * gridDim.y * gridDim.z;
    unsigned sum, cnt, mine, sp = 0u;
    for (;;) {
        sum = 0u; cnt = 0u; mine = 0u;
#pragma unroll
        for (unsigned j = 0; j < 16; ++j) { const unsigned c = xb_ld(&bar[XB_XCNT(j)]); sum += c; cnt += (c > 0u) ? 1u : 0u; mine = (j == x) ? c : mine; }
        if (sum == G) break;
        __builtin_amdgcn_s_sleep(1);
        if ((++sp & 255u) == 0u) { if (xb_ld(&bar[XB_TMO])) break; if (sp > XB_SPIN_CAP) { atomicAdd(&bar[XB_TMO], 1u); break; } }
    }
    nloc = mine > 0u ? mine : 1u; nx = cnt > 0u ? cnt : 1u;
}
__device__ __forceinline__ void xcd_barrier(const XcdBarrier& b) {
    asm volatile("s_waitcnt vmcnt(0)" ::: "memory");
    __syncthreads();
    if (threadIdx.x == 0) {
        unsigned* bar = b.bar;
        __builtin_amdgcn_s_waitcnt(0);
        unsigned nloc = b.st[0], nx = b.st[1];
        if (nloc == 0u) { xcd_barrier_complete(bar, b.x, nloc, nx); b.st[0] = nloc; b.st[1] = nx; }
        const unsigned old = xb_add(&bar[XB_XSUB(b.x)], 1u);
        const unsigned gen = old / nloc;
        if (old + 1u == (gen + 1u) * nloc) {
            __builtin_amdgcn_fence(__ATOMIC_RELEASE, "agent");
            asm volatile("s_waitcnt vmcnt(0)" ::: "memory");
            const unsigned og = xb_add(&bar[XB_TOP], 1u);
            const unsigned tg = og / nx;
            if (og + 1u == (tg + 1u) * nx) xb_add(&bar[XB_TOPGEN], 1u);
            else XB_SPIN(xb_ld(&bar[XB_TOPGEN]) == tg, bar);
            __builtin_amdgcn_fence(__ATOMIC_ACQUIRE, "agent");
            xb_add(&bar[XB_XGEN(b.x)], 1u);
            asm volatile("s_waitcnt vmcnt(0)" ::: "memory");
        } else {
            XB_SPIN(xb_ld(&bar[XB_XGEN(b.x)]) == gen, bar);
            __builtin_amdgcn_fence(__ATOMIC_ACQUIRE, "agent");
            asm volatile("s_waitcnt vmcnt(0)" ::: "memory");
        }
    }
    __syncthreads();
}

#define LDS_BYTES 75776
#define LDS_XB_OFF 75760

__device__ __forceinline__ void p0_modvec(const Params& p, float* lds_f, int task) {
    const int l = task / 96, cc = task % 96;
    const int tid = threadIdx.x, lane = tid & 63, w = tid >> 6;
    for (int i = tid; i < 3072; i += 256) {
        const int v = i >> 10, k = i & 1023;
        const float c = (v < 2) ? p.c[v * 1024 + k] : p.c_ctx[k];
        lds_f[i] = c / (1.f + __expf(-c));
    }
    __syncthreads();
    const float* W = p.mod_w + (size_t)l * 1024 * 6144 + cc * 64 + lane;
    float a0 = 0.f, a1 = 0.f, a2 = 0.f;
    const int k0 = w * 256;
#pragma unroll 8
    for (int k = 0; k < 256; ++k) {
        const float wv = W[(size_t)(k0 + k) * 6144];
        a0 += wv * lds_f[k0 + k]; a1 += wv * lds_f[1024 + k0 + k]; a2 += wv * lds_f[2048 + k0 + k];
    }
    float* red = lds_f + 3072;
    red[(w * 3 + 0) * 64 + lane] = a0; red[(w * 3 + 1) * 64 + lane] = a1; red[(w * 3 + 2) * 64 + lane] = a2;
    __syncthreads();
    if (tid < 192) {
        const int v = tid >> 6, ln = tid & 63;
        const float s = red[(0 * 3 + v) * 64 + ln] + red[(1 * 3 + v) * 64 + ln] + red[(2 * 3 + v) * 64 + ln] + red[(3 * 3 + v) * 64 + ln];
        const int col = cc * 64 + ln;
        float* modv = (float*)(p.ws + WS_MODV);
        modv[(l * 3 + v) * 6144 + col] = s + p.mod_b[l * 6144 + col];
    }
    __syncthreads();
}

struct TrD { const float* src; bf16_t* dst; int K, N; };
__device__ __forceinline__ void p0_transpose_tile(const TrD d, int tile, float* lds_f) {
    const int tilesK = d.K >> 6;
    const int tn = tile / tilesK, tk = tile % tilesK;
    const int n0 = tn * 64, k0 = tk * 64;
    const int tid = threadIdx.x;
#pragma unroll
    for (int i = 0; i < 4; ++i) {
        const int r = (tid >> 4) + 16 * i, c4 = (tid & 15) * 4;
        f32x4 v = {0.f, 0.f, 0.f, 0.f};
        if (n0 + c4 < d.N) v = *(const f32x4*)(d.src + (size_t)(k0 + r) * d.N + n0 + c4);
        float* q = lds_f + r * 65 + c4;
        q[0] = v[0]; q[1] = v[1]; q[2] = v[2]; q[3] = v[3];
    }
    __syncthreads();
    {
        const int n = tid >> 2, kc = (tid & 3) * 16;
        unsigned w[8];
#pragma unroll
        for (int j = 0; j < 8; ++j) w[j] = cvt_pk_bf16(lds_f[(kc + 2 * j) * 65 + n], lds_f[(kc + 2 * j + 1) * 65 + n]);
        bf16_t* o = d.dst + (size_t)(n0 + n) * d.K + k0 + kc;
        *(u32x4*)o = (u32x4){w[0], w[1], w[2], w[3]};
        *(u32x4*)(o + 8) = (u32x4){w[4], w[5], w[6], w[7]};
    }
    __syncthreads();
}

__device__ __forceinline__ void cvt_flat(const float* src, bf16_t* dst, size_t n) {
    const size_t nth = (size_t)gridDim.x * 256;
    for (size_t i = ((size_t)blockIdx.x * 256 + threadIdx.x) * 8; i < n; i += nth * 8) {
        const f32x4 a = *(const f32x4*)(src + i), b = *(const f32x4*)(src + i + 4);
        *(u32x4*)(dst + i) = (u32x4){cvt_pk_bf16(a[0], a[1]), cvt_pk_bf16(a[2], a[3]), cvt_pk_bf16(b[0], b[1]), cvt_pk_bf16(b[2], b[3])};
    }
}

__device__ __forceinline__ void phase0(const Params& p, unsigned char* lds) {
    float* lds_f = (float*)lds;
    for (int t = blockIdx.x; t < 192; t += gridDim.x) p0_modvec(p, lds_f, t);
    unsigned char* ws = p.ws;
#define TRANSPOSE(SRC, DSTOFF, KK, NN, NPAD) do { const TrD d_{(SRC), (bf16_t*)(ws + (DSTOFF)), (KK), (NN)}; \
        for (int t = blockIdx.x; t < ((NPAD) / 64) * ((KK) / 64); t += gridDim.x) p0_transpose_tile(d_, t, lds_f); } while (0)
    TRANSPOSE(p.ab_w_in, WS_WIN_T, 1024, 1184, 1280);
    TRANSPOSE(p.q_b_w, WS_QB_T, 384, 768, 768);
    TRANSPOSE(p.kv_b_w, WS_KVB_T, 256, 1024, 1024);
    for (int g = 0; g < 4; ++g) TRANSPOSE(p.pool_w + g * 128 * 128, WS_POOL_T + (unsigned long long)g * 128 * 128 * 2, 128, 128, 128);
    TRANSPOSE(p.ab_w_out, WS_WOUT_T, 1024, 1024, 1024);
    TRANSPOSE(p.c_w_in, WS_CIN_T, 1024, 3072, 3072);
    TRANSPOSE(p.c_w_out, WS_COUT_T, 1024, 1024, 1024);
    TRANSPOSE(p.peer_wq, WS_WQ_T, 1024, 1024, 1024);
    TRANSPOSE(p.peer_wq + 1024 * 1024, WS_WQ_T + 2097152ull, 1024, 1024, 1024);
#undef TRANSPOSE
    cvt_flat(p.peer_keys, (bf16_t*)(p.ws + WS_KEYS), 262144);
    cvt_flat(p.peer_u, (bf16_t*)(p.ws + WS_UTAB), (size_t)2 * NEXP * DM);
    cvt_flat(p.peer_v, (bf16_t*)(p.ws + WS_VTAB), (size_t)2 * NEXP * DM);
}

__device__ __forceinline__ void rowmod_phase(const Params& p, const float* src_lat, const float* src_ctx, const float* gain, int layer, int shift_idx, bf16_t* dst, int nrows) {
    const int lane = threadIdx.x & 63, w = threadIdx.x >> 6;
    const float* modv = (const float*)(p.ws + WS_MODV) + (size_t)layer * 3 * 6144;
    for (int row = blockIdx.x * 4 + w; row < nrows; row += gridDim.x * 4) {
        const float* src; int v;
        if (row < NTOK) { src = src_lat + (size_t)row * DM; v = row >> 14; }
        else { src = src_ctx + (size_t)(row - NTOK) * DM; v = 2; }
        const float* sh = modv + v * 6144 + shift_idx * 1024;
        const float* sc = sh + 1024;
        f32x4 x[4]; float ss = 0.f;
#pragma unroll
        for (int i = 0; i < 4; ++i) { x[i] = *(const f32x4*)(src + i * 256 + lane * 4); ss += x[i][0] * x[i][0] + x[i][1] * x[i][1] + x[i][2] * x[i][2] + x[i][3] * x[i][3]; }
        ss = wave_sum(ss);
        const float rstd = rsqrtf(ss * (1.0f / 1024.0f) + 1e-6f);
#pragma unroll
        for (int i = 0; i < 4; ++i) {
            const int d0 = i * 256 + lane * 4;
            const f32x4 g = *(const f32x4*)(gain + d0), s = *(const f32x4*)(sh + d0), c = *(const f32x4*)(sc + d0);
            float y[4];
#pragma unroll
            for (int j = 0; j < 4; ++j) y[j] = x[i][j] * rstd * g[j] * (1.f + c[j]) + s[j];
            *(u32x2*)(dst + (size_t)row * DM + d0) = (u32x2){cvt_pk_bf16(y[0], y[1]), cvt_pk_bf16(y[2], y[3])};
        }
    }
}

#define EPI_BF16   0
#define EPI_RESID  1
struct GemmArgs {
    const bf16_t* A; int lda;
    const bf16_t* Bt; int ldb;
    int K;
    bf16_t* C; int ldc; const float* colscale;
    const float* xin; float* xout; const float* gate; int gate_bstride;
};

__device__ __forceinline__ int swz(int row, int ch) { return row * 128 + ((ch ^ ((row >> 1) & 7)) << 4); }

template <int EPI>
__device__ __forceinline__ void gemm_tile(const GemmArgs& g, int tm, int tn, unsigned char* lds) {
    const int tid = threadIdx.x, lane = tid & 63, w = tid >> 6;
    const int wm = w >> 1, wn = w & 1;
    const int lr = lane & 15, lg = lane >> 4;
    const bf16_t* Ag = g.A + (size_t)(tm * 128) * g.lda;
    const bf16_t* Bg = g.Bt + (size_t)(tn * 128) * g.ldb;
    f32x4 acc[4][4];
#pragma unroll
    for (int i = 0; i < 4; ++i)
#pragma unroll
        for (int j = 0; j < 4; ++j) acc[i][j] = (f32x4){0.f, 0.f, 0.f, 0.f};
    u32x4 ra[4], rb[4];
    const int nk = g.K >> 6;
#pragma unroll
    for (int i = 0; i < 4; ++i) {
        const int c = tid + 256 * i, row = c >> 3, ch = c & 7;
        ra[i] = *(const u32x4*)(Ag + (size_t)row * g.lda + ch * 8);
        rb[i] = *(const u32x4*)(Bg + (size_t)row * g.ldb + ch * 8);
    }
#pragma unroll
    for (int i = 0; i < 4; ++i) {
        const int c = tid + 256 * i, row = c >> 3, ch = c & 7;
        *(u32x4*)(lds + swz(row, ch)) = ra[i];
        *(u32x4*)(lds + 16384 + swz(row, ch)) = rb[i];
    }
    __syncthreads();
    for (int kt = 0; kt < nk; ++kt) {
        const int cur = kt & 1;
        unsigned char* sAc = lds + cur * 32768; unsigned char* sBc = sAc + 16384;
        unsigned char* sAn = lds + (cur ^ 1) * 32768; unsigned char* sBn = sAn + 16384;
        if (kt + 1 < nk) {
            const int k0 = (kt + 1) * 64;
#pragma unroll
            for (int i = 0; i < 4; ++i) {
                const int c = tid + 256 * i, row = c >> 3, ch = c & 7;
                ra[i] = *(const u32x4*)(Ag + (size_t)row * g.lda + k0 + ch * 8);
                rb[i] = *(const u32x4*)(Bg + (size_t)row * g.ldb + k0 + ch * 8);
            }
        }
#pragma unroll
        for (int ks = 0; ks < 2; ++ks) {
            bf16x8 af[4], bfr[4];
#pragma unroll
            for (int i = 0; i < 4; ++i) {
                af[i]  = *(const bf16x8*)(sAc + swz(wm * 64 + i * 16 + lr, ks * 4 + lg));
                bfr[i] = *(const bf16x8*)(sBc + swz(wn * 64 + i * 16 + lr, ks * 4 + lg));
            }
#pragma unroll
            for (int i = 0; i < 4; ++i)
#pragma unroll
                for (int j = 0; j < 4; ++j) acc[i][j] = __builtin_amdgcn_mfma_f32_16x16x32_bf16(bfr[j], af[i], acc[i][j], 0, 0, 0);
        }
        if (kt + 1 < nk) {
#pragma unroll
            for (int i = 0; i < 4; ++i) {
                const int c = tid + 256 * i, row = c >> 3, ch = c & 7;
                *(u32x4*)(sAn + swz(row, ch)) = ra[i];
                *(u32x4*)(sBn + swz(row, ch)) = rb[i];
            }
        }
        __syncthreads();
    }
#pragma unroll
    for (int i = 0; i < 4; ++i) {
        const int row = tm * 128 + wm * 64 + i * 16 + lr;
#pragma unroll
        for (int j = 0; j < 4; ++j) {
            const int col = tn * 128 + wn * 64 + j * 16 + lg * 4;
            f32x4 v = acc[i][j];
            if (EPI == EPI_BF16) {
                if (g.colscale) { const f32x4 s = *(const f32x4*)(g.colscale + col); v = v * s; }
                *(u32x2*)(g.C + (size_t)row * g.ldc + col) = (u32x2){cvt_pk_bf16(v[0], v[1]), cvt_pk_bf16(v[2], v[3])};
            } else {
                const f32x4 gt = *(const f32x4*)(g.gate + (size_t)(row >> 14) * g.gate_bstride + col);
                const f32x4 xi = *(const f32x4*)(g.xin + (size_t)row * DM + col);
                *(f32x4*)(g.xout + (size_t)row * DM + col) = xi + gt * v;
            }
        }
    }
}

template <int EPI>
__device__ __forceinline__ void gemm_phase(const GemmArgs& g, int ntm, int ntn, unsigned char* lds) {
    const int nt = ntm * ntn;
    for (int t = blockIdx.x; t < nt; t += gridDim.x) gemm_tile<EPI>(g, t / ntn, t % ntn, lds);
}

__device__ __forceinline__ void latent_norm_phase(const Params& p) {
    const int lane = threadIdx.x & 63, w = threadIdx.x >> 6;
    const bf16_t* h0 = (const bf16_t*)(p.ws + WS_R + R_H0);
    bf16_t* hqn = (bf16_t*)(p.ws + WS_R + R_HQN);
    bf16_t* ckvn = (bf16_t*)(p.ws + WS_R + R_CKVN);
    for (int row = blockIdx.x * 4 + w; row < MROWS; row += gridDim.x * 4) {
        const bf16_t* hr = h0 + (size_t)row * H0LD;
        {
            const unsigned* s = (const unsigned*)(hr + lane * 6);
            const unsigned a = s[0], b = s[1], c = s[2];
            float v[6] = {bf_lo(a), bf_hi(a), bf_lo(b), bf_hi(b), bf_lo(c), bf_hi(c)};
            float ss = 0.f;
#pragma unroll
            for (int j = 0; j < 6; ++j) ss += v[j] * v[j];
            ss = wave_sum(ss);
            const float rstd = rsqrtf(ss * (1.0f / 384.0f) + 1e-6f);
            const float* gn = p.q_a_norm + lane * 6;
            unsigned* o = (unsigned*)(hqn + (size_t)row * 384 + lane * 6);
            o[0] = cvt_pk_bf16(v[0] * rstd * gn[0], v[1] * rstd * gn[1]);
            o[1] = cvt_pk_bf16(v[2] * rstd * gn[2], v[3] * rstd * gn[3]);
            o[2] = cvt_pk_bf16(v[4] * rstd * gn[4], v[5] * rstd * gn[5]);
        }
        {
            const u32x2 s = *(const u32x2*)(hr + 384 + lane * 4);
            float v[4] = {bf_lo(s[0]), bf_hi(s[0]), bf_lo(s[1]), bf_hi(s[1])};
            float ss = v[0] * v[0] + v[1] * v[1] + v[2] * v[2] + v[3] * v[3];
            ss = wave_sum(ss);
            const float rstd = rsqrtf(ss * (1.0f / 256.0f) + 1e-6f);
            const float* gn = p.kv_a_norm + lane * 4;
            *(u32x2*)(ckvn + (size_t)row * 256 + lane * 4) = (u32x2){cvt_pk_bf16(v[0] * rstd * gn[0], v[1] * rstd * gn[1]), cvt_pk_bf16(v[2] * rstd * gn[2], v[3] * rstd * gn[3])};
        }
    }
}

__device__ __forceinline__ void rope32(float* v  , int t) {
    const float inv[8] = {1.0f, 0.31622776601683794f, 0.1f, 0.031622776601683794f, 0.01f, 0.0031622776601683794f, 0.001f, 0.00031622776601683794f};
    const float pos[2] = {(float)(t >> 6), (float)(t & 63)};
#pragma unroll
    for (int a = 0; a < 2; ++a)
#pragma unroll
        for (int i = 0; i < 8; ++i) {
            const float ang = pos[a] * inv[i];
            float rev = ang * 0.15915494309189535f;
            rev = rev - floorf(rev);
            const float sn = __builtin_amdgcn_sinf(rev), cs = __builtin_amdgcn_cosf(rev);
            const float x1 = v[a * 16 + i], x2 = v[a * 16 + 8 + i];
            v[a * 16 + i] = x1 * cs - x2 * sn;
            v[a * 16 + 8 + i] = x2 * cs + x1 * sn;
        }
}

__device__ __forceinline__ void norm_rope_store(const u32x4 (&c)[12], const float* gains, bool do_rope, int t, float outscale, bf16_t* dst) {
    float ss = 0.f;
#pragma unroll
    for (int cc = 0; cc < 12; ++cc)
#pragma unroll
        for (int j = 0; j < 4; ++j) { const float lo = bf_lo(c[cc][j]), hi = bf_hi(c[cc][j]); ss += lo * lo + hi * hi; }
    const float rstd = rsqrtf(ss * (1.0f / 96.0f) + 1e-6f);
    const float rs = rstd * outscale;
#pragma unroll
    for (int cc = 0; cc < 8; ++cc) {
        u32x4 o;
#pragma unroll
        for (int j = 0; j < 4; ++j) o[j] = cvt_pk_bf16(bf_lo(c[cc][j]) * rs * gains[cc * 8 + 2 * j], bf_hi(c[cc][j]) * rs * gains[cc * 8 + 2 * j + 1]);
        *(u32x4*)(dst + cc * 8) = o;
    }
    float v[32];
#pragma unroll
    for (int cc = 0; cc < 4; ++cc)
#pragma unroll
        for (int j = 0; j < 4; ++j) { v[cc * 8 + 2 * j] = bf_lo(c[8 + cc][j]) * rstd * gains[64 + cc * 8 + 2 * j]; v[cc * 8 + 2 * j + 1] = bf_hi(c[8 + cc][j]) * rstd * gains[64 + cc * 8 + 2 * j + 1]; }
    if (do_rope) rope32(v, t);
#pragma unroll
    for (int cc = 0; cc < 4; ++cc) {
        u32x4 o;
#pragma unroll
        for (int j = 0; j < 4; ++j) o[j] = cvt_pk_bf16(v[cc * 8 + 2 * j] * outscale, v[cc * 8 + 2 * j + 1] * outscale);
        *(u32x4*)(dst + 64 + cc * 8) = o;
    }
}

__device__ __forceinline__ void qkv_post_phase(const Params& p, unsigned char* lds) {
    const int tid = threadIdx.x;
    const size_t gth = (size_t)blockIdx.x * 256 + tid, nth = (size_t)gridDim.x * 256;
    {
        bf16_t* Q = (bf16_t*)(p.ws + WS_R + R_Q);
        const float qs = 0.10206207261596575f * 1.4426950408889634f;
        for (size_t i = gth; i < (size_t)NTOK * NHEAD; i += nth) {
            const int tok = (int)(i >> 3);
            bf16_t* q = Q + i * QKD;
            u32x4 c[12];
#pragma unroll
            for (int cc = 0; cc < 12; ++cc) c[cc] = *(const u32x4*)(q + cc * 8);
            norm_rope_store(c, p.q_norm, true, tok & (SEQ - 1), qs, q);
        }
    }
    {
        const bf16_t* kv = (const bf16_t*)(p.ws + WS_A0);
        const bf16_t* h0 = (const bf16_t*)(p.ws + WS_R + R_H0);
        bf16_t* K = (bf16_t*)(p.ws + WS_R + R_K);
        for (size_t i = gth; i < (size_t)MROWS * NHEAD; i += nth) {
            const int row = (int)(i >> 3), hd = (int)(i & 7);
            int b, s, t; bool lat;
            if (row < NTOK) { b = row >> 14; t = row & (SEQ - 1); s = CTXL + t; lat = true; }
            else { const int rc = row - NTOK; b = rc >> 8; s = rc & 255; t = 0; lat = false; }
            u32x4 c[12];
            const bf16_t* kn = kv + (size_t)row * 1024 + hd * 128;
#pragma unroll
            for (int cc = 0; cc < 8; ++cc) c[cc] = *(const u32x4*)(kn + cc * 8);
            const bf16_t* kr = h0 + (size_t)row * H0LD + 640;
#pragma unroll
            for (int cc = 0; cc < 4; ++cc) c[8 + cc] = *(const u32x4*)(kr + cc * 8);
            norm_rope_store(c, p.k_norm, lat, t, 1.0f, K + ((size_t)(b * NHEAD + hd) * SKEYS + s) * QKD);
        }
    }
    {
        const bf16_t* kv = (const bf16_t*)(p.ws + WS_A0);
        bf16_t* Vt = (bf16_t*)(p.ws + WS_R + R_VT);
        bf16_t* tl = (bf16_t*)lds;
        const int ntile = 2 * NHEAD * (SKEYS / 64);
        for (int it = blockIdx.x; it < ntile; it += gridDim.x) {
            const int st = it % (SKEYS / 64), bh = it / (SKEYS / 64), b = bh >> 3, hd = bh & 7;
            const int s0 = st * 64;
            const int row0 = (s0 < CTXL) ? (NTOK + b * CTXL + s0) : (b * SEQ + s0 - CTXL);
            {
                const int key = tid >> 2, c16 = (tid & 3) * 16;
                const bf16_t* src = kv + (size_t)(row0 + key) * 1024 + hd * 128 + 64 + c16;
                const u32x4 u0 = *(const u32x4*)src, u1 = *(const u32x4*)(src + 8);
#pragma unroll
                for (int j = 0; j < 4; ++j) {
                    tl[(c16 + 2 * j) * 72 + key] = (bf16_t)(u0[j] & 0xffffu); tl[(c16 + 2 * j + 1) * 72 + key] = (bf16_t)(u0[j] >> 16);
                    tl[(c16 + 8 + 2 * j) * 72 + key] = (bf16_t)(u1[j] & 0xffffu); tl[(c16 + 8 + 2 * j + 1) * 72 + key] = (bf16_t)(u1[j] >> 16);
                }
            }
            __syncthreads();
            {
                const int dv = tid >> 2, c16 = (tid & 3) * 16;
                const u32x4 u0 = *(const u32x4*)(tl + dv * 72 + c16), u1 = *(const u32x4*)(tl + dv * 72 + c16 + 8);
                bf16_t* o = Vt + ((size_t)(bh * VD + dv)) * SKEYS + s0 + c16;
                *(u32x4*)o = u0; *(u32x4*)(o + 8) = u1;
            }
            __syncthreads();
        }
    }
    {
        const bf16_t* h0 = (const bf16_t*)(p.ws + WS_R + R_H0);
        bf16_t* pooled = (bf16_t*)(p.ws + WS_R + R_HQN);
        for (size_t i = gth; i < (size_t)NTOK * 64; i += nth) {
            const int tok = (int)(i >> 6), ch = (int)(i & 63);
            const int b = tok >> 14, t = tok & (SEQ - 1);
            const int grp = ch >> 4, wdw = 2 << grp;
            int lo = t - (wdw >> 1), hi = t + (wdw >> 1);
            lo = lo < 0 ? 0 : lo; hi = hi > SEQ ? SEQ : hi;
            float sum[8] = {0.f, 0.f, 0.f, 0.f, 0.f, 0.f, 0.f, 0.f}, self[8];
            const bf16_t* base = h0 + (size_t)(b * SEQ) * H0LD + 672 + ch * 8;
            for (int tt = lo; tt < hi; ++tt) {
                const u32x4 u = *(const u32x4*)(base + (size_t)tt * H0LD);
#pragma unroll
                for (int j = 0; j < 4; ++j) { sum[2 * j] += bf_lo(u[j]); sum[2 * j + 1] += bf_hi(u[j]); }
                if (tt == t) {
#pragma unroll
                    for (int j = 0; j < 4; ++j) { self[2 * j] = bf_lo(u[j]); self[2 * j + 1] = bf_hi(u[j]); }
                }
            }
            const float rc = 1.0f / (float)(hi - lo);
            u32x4 o;
#pragma unroll
            for (int j = 0; j < 4; ++j) o[j] = cvt_pk_bf16(sum[2 * j] * rc - self[2 * j], sum[2 * j + 1] * rc - self[2 * j + 1]);
            *(u32x4*)(pooled + (size_t)tok * 512 + ch * 8) = o;
        }
    }
}

#define AT_KROW 208
#define AT_VROW 144
#define AT_KBUF (64 * AT_KROW)
#define AT_VBUF (64 * AT_VROW)
__device__ __forceinline__ void attention_item(const Params& p, int bh, int qblk, unsigned char* lds) {
    const int tid = threadIdx.x, lane = tid & 63, w = tid >> 6;
    const int r = lane & 31, hh = lane >> 5;
    const int b = bh >> 3, hd = bh & 7;
    const bf16_t* Q = (const bf16_t*)(p.ws + WS_R + R_Q);
    const bf16_t* Kg = (const bf16_t*)(p.ws + WS_R + R_K) + (size_t)bh * SKEYS * QKD;
    const bf16_t* Vg = (const bf16_t*)(p.ws + WS_R + R_VT) + (size_t)bh * VD * SKEYS;
    bf16_t* outc = (bf16_t*)(p.ws + WS_R + R_H0);

    const int tok = b * SEQ + qblk * 128 + w * 32 + r;
    bf16x8 qf[6];
#pragma unroll
    for (int ds = 0; ds < 6; ++ds) qf[ds] = *(const bf16x8*)(Q + ((size_t)tok * NHEAD + hd) * QKD + ds * 16 + hh * 8);

    f32x16 O0, O1;
#pragma unroll
    for (int i = 0; i < 16; ++i) { O0[i] = 0.f; O1[i] = 0.f; }
    float lsum = 0.f;

    u32x4 rk[3], rv[2];
    auto load_tile = [&](int kt) {
        const bf16_t* kg = Kg + (size_t)kt * 64 * QKD;
#pragma unroll
        for (int i = 0; i < 3; ++i) rk[i] = *(const u32x4*)(kg + (size_t)(tid + 256 * i) * 8);
#pragma unroll
        for (int i = 0; i < 2; ++i) { const int c = tid + 256 * i, dv = c >> 3, ch = c & 7; rv[i] = *(const u32x4*)(Vg + (size_t)dv * SKEYS + kt * 64 + ch * 8); }
    };
    auto store_tile = [&](int buf) {
        unsigned char* sKb = lds + buf * (AT_KBUF + AT_VBUF); unsigned char* sVb = sKb + AT_KBUF;
#pragma unroll
        for (int i = 0; i < 3; ++i) { const int c = tid + 256 * i, row = c / 12, ch = c % 12; *(u32x4*)(sKb + row * AT_KROW + ch * 16) = rk[i]; }
#pragma unroll
        for (int i = 0; i < 2; ++i) { const int c = tid + 256 * i, dv = c >> 3, ch = c & 7; *(u32x4*)(sVb + dv * AT_VROW + ch * 16) = rv[i]; }
    };
    const int krow = (r & 0x13) | ((r & 4) << 1) | ((r & 8) >> 1);
    const int NT = SKEYS / 64;
    __syncthreads();
    load_tile(0); store_tile(0);
    __syncthreads();
    for (int kt = 0; kt < NT; ++kt) {
        const int cur = kt & 1;
        const unsigned char* sKc = lds + cur * (AT_KBUF + AT_VBUF); const unsigned char* sVc = sKc + AT_KBUF;
        if (kt + 1 < NT) load_tile(kt + 1);
#pragma unroll
        for (int sub = 0; sub < 2; ++sub) {
            f32x16 S;
#pragma unroll
            for (int i = 0; i < 16; ++i) S[i] = 0.f;
            const unsigned char* kb = sKc + (sub * 32 + krow) * AT_KROW + hh * 16;
#pragma unroll
            for (int ds = 0; ds < 6; ++ds) {
                const bf16x8 kf = *(const bf16x8*)(kb + ds * 32);
                S = __builtin_amdgcn_mfma_f32_32x32x16_bf16(kf, qf[ds], S, 0, 0, 0);
            }
            float ps = 0.f;
#pragma unroll
            for (int i = 0; i < 16; ++i) { S[i] = __builtin_amdgcn_exp2f(S[i]); ps += S[i]; }
            lsum += ps;
            bf16x8 pb[2];
#pragma unroll
            for (int s = 0; s < 2; ++s) {
                u32x4 u;
#pragma unroll
                for (int j = 0; j < 4; ++j) u[j] = cvt_pk_bf16(S[8 * s + 2 * j], S[8 * s + 2 * j + 1]);
                pb[s] = *(bf16x8*)&u;
            }
            const unsigned char* vb = sVc + r * AT_VROW + (sub * 32 + hh * 8) * 2;
#pragma unroll
            for (int s = 0; s < 2; ++s) {
                const bf16x8 v0 = *(const bf16x8*)(vb + s * 32);
                const bf16x8 v1 = *(const bf16x8*)(vb + 32 * AT_VROW + s * 32);
                O0 = __builtin_amdgcn_mfma_f32_32x32x16_bf16(v0, pb[s], O0, 0, 0, 0);
                O1 = __builtin_amdgcn_mfma_f32_32x32x16_bf16(v1, pb[s], O1, 0, 0, 0);
            }
        }
        if (kt + 1 < NT) store_tile(cur ^ 1);
        __syncthreads();
    }
    lsum += __shfl_xor(lsum, 32);
    const float rl = 1.0f / lsum;
    bf16_t* o = outc + (size_t)tok * 1024 + hd * 64;
#pragma unroll
    for (int g4 = 0; g4 < 4; ++g4) {
        *(u32x2*)(o + 8 * g4 + 4 * hh) = (u32x2){cvt_pk_bf16(O0[4 * g4] * rl, O0[4 * g4 + 1] * rl), cvt_pk_bf16(O0[4 * g4 + 2] * rl, O0[4 * g4 + 3] * rl)};
        *(u32x2*)(o + 32 + 8 * g4 + 4 * hh) = (u32x2){cvt_pk_bf16(O1[4 * g4] * rl, O1[4 * g4 + 1] * rl), cvt_pk_bf16(O1[4 * g4 + 2] * rl, O1[4 * g4 + 3] * rl)};
    }
}

__device__ __forceinline__ void attention_phase(const Params& p, unsigned char* lds) {
    for (int it = blockIdx.x; it < 2048; it += gridDim.x) {
        const int xcd = it & 7, j = it >> 3;
        attention_item(p, xcd * 2 + (j >> 7), j & 127, lds);
    }
}

__device__ __forceinline__ void conv_phase(const Params& p) {
    const bf16_t* h1 = (const bf16_t*)(p.ws + WS_R + R_H1);
    bf16_t* z = (bf16_t*)(p.ws + WS_R + R_Z);
    const size_t gth = (size_t)blockIdx.x * 256 + threadIdx.x, nth = (size_t)gridDim.x * 256;
    for (size_t i = gth; i < (size_t)NTOK * 128; i += nth) {
        const int tok = (int)(i >> 7), ch = (int)(i & 127) * 8;
        const int t = tok & (SEQ - 1);
        const bf16_t* hr = h1 + (size_t)tok * 3072 + ch;
        float acc[8] = {0.f, 0.f, 0.f, 0.f, 0.f, 0.f, 0.f, 0.f};
#pragma unroll
        for (int d = -1; d <= 1; ++d) {
            if (t + d < 0 || t + d >= SEQ) continue;
            const u32x4 cg = *(const u32x4*)(hr + (ptrdiff_t)d * 3072 + 1024), hv = *(const u32x4*)(hr + (ptrdiff_t)d * 3072 + 2048);
            const float* cw = p.c_conv + (d + 1) * 1024 + ch;
            const f32x4 w0 = *(const f32x4*)cw, w1 = *(const f32x4*)(cw + 4);
#pragma unroll
            for (int j = 0; j < 4; ++j) {
                const float wa = (j < 2) ? w0[2 * j] : w1[2 * j - 4], wb = (j < 2) ? w0[2 * j + 1] : w1[2 * j - 3];
                acc[2 * j] += bf_lo(cg[j]) * bf_lo(hv[j]) * wa;
                acc[2 * j + 1] += bf_hi(cg[j]) * bf_hi(hv[j]) * wb;
            }
        }
        const u32x4 bg = *(const u32x4*)hr;
        u32x4 o;
#pragma unroll
        for (int j = 0; j < 4; ++j) o[j] = cvt_pk_bf16(bf_lo(bg[j]) * acc[2 * j], bf_hi(bg[j]) * acc[2 * j + 1]);
        *(u32x4*)(z + (size_t)tok * 1024 + ch) = o;
    }
}

#define TK_LD 260
__device__ __forceinline__ void tk_insert(float (&top)[16], float x) {
#pragma unroll
    for (int j = 0; j < 16; ++j) { const float t = fmaxf(top[j], x); x = fminf(top[j], x); top[j] = t; }
}
__device__ __forceinline__ void peer_topk_phase(const Params& p, int layer, const bf16_t* qp, int* eid, float* gw, unsigned char* lds) {
    const int tid = threadIdx.x, lane = tid & 63, w = tid >> 6;
    const int lr = lane & 15, lg = lane >> 4;
    float* sc = (float*)lds;
    float* lst = (float*)(lds + 64 * TK_LD * 4);
    const bf16_t* keys = (const bf16_t*)(p.ws + WS_KEYS) + (size_t)layer * 8 * 2 * 128 * 64;
    for (int it = blockIdx.x; it < 512 * 8; it += gridDim.x) {
        const int hd = it & 7, tt = it >> 3, tok0 = tt * 64;
        {
            const int side = w >> 1, half = w & 1;
            f32x4 acc[4][4];
#pragma unroll
            for (int i = 0; i < 4; ++i)
#pragma unroll
                for (int j = 0; j < 4; ++j) acc[i][j] = (f32x4){0.f, 0.f, 0.f, 0.f};
            const bf16_t* qa = qp + (size_t)(tok0 + lr) * 1024 + hd * 128 + side * 64 + lg * 8;
            const bf16_t* kb = keys + ((size_t)(hd * 2 + side) * 128 + half * 64 + lr) * 64 + lg * 8;
#pragma unroll
            for (int ks = 0; ks < 2; ++ks) {
                bf16x8 af[4], bfr[4];
#pragma unroll
                for (int i = 0; i < 4; ++i) { af[i] = *(const bf16x8*)(qa + (size_t)i * 16 * 1024 + ks * 32); bfr[i] = *(const bf16x8*)(kb + i * 16 * 64 + ks * 32); }
#pragma unroll
                for (int i = 0; i < 4; ++i)
#pragma unroll
                    for (int j = 0; j < 4; ++j) acc[i][j] = __builtin_amdgcn_mfma_f32_16x16x32_bf16(af[i], bfr[j], acc[i][j], 0, 0, 0);
            }
#pragma unroll
            for (int i = 0; i < 4; ++i)
#pragma unroll
                for (int j = 0; j < 4; ++j)
#pragma unroll
                    for (int jj = 0; jj < 4; ++jj) sc[(i * 16 + lg * 4 + jj) * TK_LD + side * 128 + half * 64 + j * 16 + lr] = acc[i][j][jj];
        }
        __syncthreads();
        if (tid < 128) {
            const int token = tid & 63, side = tid >> 6;
            float top[16];
#pragma unroll
            for (int j = 0; j < 16; ++j) top[j] = -3.0e38f;
            const float* s = sc + token * TK_LD + side * 128;
            for (int k4 = 0; k4 < 32; ++k4) {
                const f32x4 v = *(const f32x4*)(s + k4 * 4);
#pragma unroll
                for (int e = 0; e < 4; ++e) tk_insert(top, __uint_as_float((__float_as_uint(v[e]) & ~127u) | (unsigned)(k4 * 4 + e)));
            }
#pragma unroll
            for (int j = 0; j < 16; ++j) lst[(token * 2 + side) * 16 + j] = top[j];
        }
        __syncthreads();
        if (tid < 64) {
            const int token = tid;
            float v1[16], v2[16], top[16];
#pragma unroll
            for (int j = 0; j < 16; ++j) { v1[j] = lst[(token * 2) * 16 + j]; v2[j] = lst[(token * 2 + 1) * 16 + j]; top[j] = -3.0e38f; }
#pragma unroll
            for (int i = 0; i < 16; ++i)
#pragma unroll
                for (int j = 0; j < 16; ++j)
                    if ((i + 1) * (j + 1) <= 16) {
                        const float a = __uint_as_float(__float_as_uint(v1[i]) & ~127u), bb = __uint_as_float(__float_as_uint(v2[j]) & ~127u);
                        tk_insert(top, __uint_as_float((__float_as_uint(a + bb) & ~255u) | (unsigned)(i * 16 + j)));
                    }
            const float m = top[0];
            float e[16], sum = 0.f;
#pragma unroll
            for (int j = 0; j < 16; ++j) { e[j] = __expf(top[j] - m); sum += e[j]; }
            const float rs = 1.0f / sum;
            int* eo = eid + (size_t)(tok0 + token) * 128 + hd * 16;
            float* go = gw + (size_t)(tok0 + token) * 128 + hd * 16;
#pragma unroll
            for (int j = 0; j < 16; ++j) {
                const unsigned pl = __float_as_uint(top[j]) & 255u;
                const unsigned i1 = __float_as_uint(lst[(token * 2) * 16 + (pl >> 4)]) & 127u;
                const unsigned i2 = __float_as_uint(lst[(token * 2 + 1) * 16 + (pl & 15u)]) & 127u;
                eo[j] = (int)(i1 * 128u + i2);
                go[j] = e[j] * rs;
            }
        }
        __syncthreads();
    }
}

__device__ __forceinline__ void peer_gather_phase(const Params& p, int layer, const bf16_t* xf, const int* eid, const float* gw, float* xio, unsigned char* lds) {
    const int tid = threadIdx.x, lane = tid & 63, w = tid >> 6;
    const int lr = lane & 15, lg = lane >> 4;
    unsigned char* xs = lds + w * 4096;
    float* coefs = (float*)(xs + 2048);
    const bf16_t* U = (const bf16_t*)(p.ws + WS_UTAB) + (size_t)layer * NEXP * DM;
    const bf16_t* V = (const bf16_t*)(p.ws + WS_VTAB) + (size_t)layer * NEXP * DM;
    const float* modv = (const float*)(p.ws + WS_MODV) + (size_t)layer * 3 * 6144;
    for (int tok = blockIdx.x * 4 + w; tok < NTOK; tok += gridDim.x * 4) {
        {
            const u32x4 a = *(const u32x4*)(xf + (size_t)tok * DM + lane * 8), bq = *(const u32x4*)(xf + (size_t)tok * DM + 512 + lane * 8);
            *(u32x4*)(xs + lane * 16) = a; *(u32x4*)(xs + 1024 + lane * 16) = bq;
        }
        const int e_lo = eid[(size_t)tok * 128 + lane], e_hi = eid[(size_t)tok * 128 + 64 + lane];
        const float g_lo = gw[(size_t)tok * 128 + lane], g_hi = gw[(size_t)tok * 128 + 64 + lane];
        __builtin_amdgcn_wave_barrier();
        asm volatile("s_waitcnt lgkmcnt(0)" ::: "memory");
#pragma unroll 1
        for (int blk = 0; blk < 8; ++blk) {
            const int src = (blk * 16 + lr) & 63;
            const int e = __shfl((blk < 4) ? e_lo : e_hi, src);
            const float gg = __shfl((blk < 4) ? g_lo : g_hi, src);
            const bf16_t* ur = U + (size_t)e * DM + lg * 8;
            f32x4 acc = {0.f, 0.f, 0.f, 0.f};
#pragma unroll
            for (int ks = 0; ks < 32; ++ks) {
                const bf16x8 bfr = *(const bf16x8*)(ur + ks * 32);
                const bf16x8 af = *(const bf16x8*)(xs + ks * 64 + lg * 16);
                acc = __builtin_amdgcn_mfma_f32_16x16x32_bf16(af, bfr, acc, 0, 0, 0);
            }
            const float a = acc[0];
            const float ge = 0.5f * a * (1.0f + erff(a * 0.70710678118654752f));
            if (lane < 16) coefs[blk * 16 + lane] = gg * ge;
        }
        __builtin_amdgcn_wave_barrier();
        asm volatile("s_waitcnt lgkmcnt(0)" ::: "memory");
        float o[16];
#pragma unroll
        for (int j = 0; j < 16; ++j) o[j] = 0.f;
#pragma unroll 1
        for (int half = 0; half < 2; ++half) {
            const int ev = half ? e_hi : e_lo;
#pragma unroll 8
            for (int i = 0; i < 64; ++i) {
                const int e = __builtin_amdgcn_readlane(ev, i);
                const float cf = coefs[half * 64 + i];
                const bf16_t* vr = V + (size_t)e * DM + lane * 8;
                const u32x4 a = *(const u32x4*)vr, bq = *(const u32x4*)(vr + 512);
#pragma unroll
                for (int j = 0; j < 4; ++j) {
                    o[2 * j] += cf * bf_lo(a[j]); o[2 * j + 1] += cf * bf_hi(a[j]);
                    o[8 + 2 * j] += cf * bf_lo(bq[j]); o[8 + 2 * j + 1] += cf * bf_hi(bq[j]);
                }
            }
        }
        const float* gate = modv + (tok >> 14) * 6144 + 5 * 1024;
        float* xr = xio + (size_t)tok * DM;
#pragma unroll
        for (int h2 = 0; h2 < 2; ++h2)
#pragma unroll
            for (int q4 = 0; q4 < 2; ++q4) {
                const int d0 = h2 * 512 + lane * 8 + q4 * 4;
                const f32x4 gt = *(const f32x4*)(gate + d0);
                f32x4 xv = *(const f32x4*)(xr + d0);
#pragma unroll
                for (int j = 0; j < 4; ++j) xv[j] += gt[j] * o[h2 * 8 + q4 * 4 + j];
                *(f32x4*)(xr + d0) = xv;
            }
        __builtin_amdgcn_wave_barrier();
    }
}

#ifndef STOP_PHASE
#define STOP_PHASE 1000
#endif
#if USE_CG
#define PHASE_END(n) do { cg::this_grid().sync(); if (STOP_PHASE == (n)) return; } while (0)
#else
#define PHASE_END(n) do { xcd_barrier(xb); if (STOP_PHASE == (n)) return; } while (0)
#endif

__global__ void __launch_bounds__(256, 2) fwd_megakernel(Params p) {
    __shared__ __attribute__((aligned(16))) unsigned char lds[LDS_BYTES];
    if (threadIdx.x == 0) { *(u32x4*)(lds + LDS_XB_OFF) = (u32x4){0u, 0u, 0u, 0u}; }
    __syncthreads();
    XcdBarrier xb = xcd_barrier_post((unsigned*)(p.ws + WS_BAR), (volatile LAS unsigned*)(lds + LDS_XB_OFF));
    unsigned char* ws = p.ws;
    const float* modv = (const float*)(ws + WS_MODV);
    bf16_t* A0 = (bf16_t*)(ws + WS_A0);

    phase0(p, lds);
    PHASE_END(0);
    rowmod_phase(p, p.x, p.ctx, p.norm_mix, 0, 0, A0, MROWS);
    PHASE_END(1);
    {
        GemmArgs g{}; g.A = A0; g.lda = 1024; g.Bt = (const bf16_t*)(ws + WS_WIN_T); g.ldb = 1024; g.K = 1024;
        g.C = (bf16_t*)(ws + WS_R + R_H0); g.ldc = H0LD; g.colscale = nullptr;
        gemm_phase<EPI_BF16>(g, MROWS / 128, H0LD / 128, lds);
    }
    PHASE_END(2);
    latent_norm_phase(p);
    PHASE_END(3);
    {
        GemmArgs g{}; g.A = (const bf16_t*)(ws + WS_R + R_HQN); g.lda = 384; g.Bt = (const bf16_t*)(ws + WS_QB_T); g.ldb = 384; g.K = 384;
        g.C = (bf16_t*)(ws + WS_R + R_Q); g.ldc = 768; g.colscale = nullptr;
        GemmArgs g2{}; g2.A = (const bf16_t*)(ws + WS_R + R_CKVN); g2.lda = 256; g2.Bt = (const bf16_t*)(ws + WS_KVB_T); g2.ldb = 256; g2.K = 256;
        g2.C = A0; g2.ldc = 1024; g2.colscale = nullptr;
        const int n1 = (NTOK / 128) * 6, n2 = (MROWS / 128) * 8;
        for (int t = blockIdx.x; t < n1 + n2; t += gridDim.x) {
            if (t < n1) gemm_tile<EPI_BF16>(g, t / 6, t % 6, lds);
            else { const int u = t - n1; gemm_tile<EPI_BF16>(g2, u / 8, u % 8, lds); }
        }
    }
    PHASE_END(4);
    qkv_post_phase(p, lds);
    PHASE_END(5);
    {
        for (int t = blockIdx.x; t < 4 * (NTOK / 128); t += gridDim.x) {
            const int grp = t & 3, tm = t >> 2;
            GemmArgs g{}; g.A = (const bf16_t*)(ws + WS_R + R_HQN) + grp * 128; g.lda = 512; g.Bt = (const bf16_t*)(ws + WS_POOL_T) + grp * 128 * 128; g.ldb = 128; g.K = 128;
            g.C = (bf16_t*)(ws + WS_R + R_H0) + 512 + grp * 128; g.ldc = 1024; g.colscale = p.pool_scale + grp * 128;
            gemm_tile<EPI_BF16>(g, tm, 0, lds);
        }
    }
    PHASE_END(6);
    attention_phase(p, lds);
    PHASE_END(7);
    {
        GemmArgs g{}; g.A = (const bf16_t*)(ws + WS_R + R_H0); g.lda = 1024; g.Bt = (const bf16_t*)(ws + WS_WOUT_T); g.ldb = 1024; g.K = 1024;
        g.xin = p.x; g.xout = p.out; g.gate = modv + 2 * 1024; g.gate_bstride = 6144;
        gemm_phase<EPI_RESID>(g, NTOK / 128, 8, lds);
    }
    PHASE_END(8);
    rowmod_phase(p, p.out, p.ctx, p.norm_ffn, 0, 3, A0, NTOK);
    PHASE_END(9);
    {
        GemmArgs g{}; g.A = A0; g.lda = 1024; g.Bt = (const bf16_t*)(ws + WS_WQ_T); g.ldb = 1024; g.K = 1024;
        g.C = (bf16_t*)(ws + WS_R + R_Q); g.ldc = 1024; g.colscale = nullptr;
        gemm_phase<EPI_BF16>(g, NTOK / 128, 8, lds);
    }
    PHASE_END(10);
    peer_topk_phase(p, 0, (const bf16_t*)(ws + WS_R + R_Q), (int*)(ws + WS_R + R_VT), (float*)(ws + WS_R + R_VT + 16777216ull), lds);
    PHASE_END(11);
    peer_gather_phase(p, 0, A0, (const int*)(ws + WS_R + R_VT), (const float*)(ws + WS_R + R_VT + 16777216ull), p.out, lds);
    PHASE_END(12);
    rowmod_phase(p, p.out, p.ctx, p.norm_mix + 1024, 1, 0, A0, NTOK);
    PHASE_END(13);
    {
        GemmArgs g{}; g.A = A0; g.lda = 1024; g.Bt = (const bf16_t*)(ws + WS_CIN_T); g.ldb = 1024; g.K = 1024;
        g.C = (bf16_t*)(ws + WS_R + R_H1); g.ldc = 3072; g.colscale = nullptr;
        gemm_phase<EPI_BF16>(g, NTOK / 128, 24, lds);
    }
    PHASE_END(14);
    conv_phase(p);
    PHASE_END(15);
    {
        GemmArgs g{}; g.A = (const bf16_t*)(ws + WS_R + R_Z); g.lda = 1024; g.Bt = (const bf16_t*)(ws + WS_COUT_T); g.ldb = 1024; g.K = 1024;
        g.xin = p.out; g.xout = p.out; g.gate = modv + 3 * 6144 + 2 * 1024; g.gate_bstride = 6144;
        gemm_phase<EPI_RESID>(g, NTOK / 128, 8, lds);
    }
    PHASE_END(16);
    rowmod_phase(p, p.out, p.ctx, p.norm_ffn + 1024, 1, 3, A0, NTOK);
    PHASE_END(17);
    {
        GemmArgs g{}; g.A = A0; g.lda = 1024; g.Bt = (const bf16_t*)(ws + WS_WQ_T) + 1024 * 1024; g.ldb = 1024; g.K = 1024;
        g.C = (bf16_t*)(ws + WS_R + R_H1); g.ldc = 1024; g.colscale = nullptr;
        gemm_phase<EPI_BF16>(g, NTOK / 128, 8, lds);
    }
    PHASE_END(18);
    peer_topk_phase(p, 1, (const bf16_t*)(ws + WS_R + R_H1), (int*)(ws + WS_R + 67108864ull), (float*)(ws + WS_R + 67108864ull + 16777216ull), lds);
    PHASE_END(19);
    peer_gather_phase(p, 1, A0, (const int*)(ws + WS_R + 67108864ull), (const float*)(ws + WS_R + 67108864ull + 16777216ull), p.out, lds);
}

extern "C" void kernel_launch(void* const* d_in, const int* in_sizes, int n_in, void* d_out, int out_size, void* d_ws, size_t ws_size, hipStream_t stream) {
    static int grid = 0;
    if (grid == 0) {
        if (n_in != 25 || out_size != NTOK * DM || ws_size < WS_TOTAL) {
            fprintf(stderr, "kernel_launch: unexpected sizes (n_in %d, out %d, ws %zu, need %llu)\n", n_in, out_size, ws_size, (unsigned long long)WS_TOTAL);
            grid = -1; return;
        }
        int dev = 0, cus = 0, per_cu = 0;
        (void)hipGetDevice(&dev);
        (void)hipDeviceGetAttribute(&cus, hipDeviceAttributeMultiprocessorCount, dev);
        if (hipOccupancyMaxActiveBlocksPerMultiprocessor(&per_cu, (const void*)fwd_megakernel, 256, 0) != hipSuccess || per_cu < 1) { fprintf(stderr, "kernel_launch: occupancy query failed\n"); grid = -1; return; }
        if (per_cu > 2) per_cu = 2;
        grid = cus * per_cu;
    }
    if (grid < 0) return;
    Params p{};
    const float** f = (const float**)&p.x;
    for (int i = 0; i < 25; ++i) f[i] = (const float*)d_in[i];
    p.out = (float*)d_out; p.ws = (unsigned char*)d_ws;
    (void)hipMemsetAsync(d_ws, 0, XCD_BAR_WORDS * 4, stream);
#if USE_CG
    void* args[] = {&p};
    hipError_t e = hipLaunchCooperativeKernel((const void*)fwd_megakernel, dim3(grid), dim3(256), args, 0, stream);
    if (e != hipSuccess) fprintf(stderr, "cooperative launch failed: %s (grid %d)\n", hipGetErrorString(e), grid);
#else
    hipLaunchKernelGGL(fwd_megakernel, dim3(grid), dim3(256), 0, stream, p);
#endif
}
```

```cpp
#include <hip/hip_runtime.h>
#include <stdint.h>
#include <stdio.h>
#include <hip/hip_cooperative_groups.h>
namespace cg = cooperative_groups;
#ifndef USE_CG
#define USE_CG 0
#endif

#define NTOK   32768
#define SEQ    16384
#define DM     1024
#define CTXL   256
#define MROWS  33280
#define SKEYS  16640
#define NHEAD  8
#define QKD    96
#define VD     64
#define H0LD   1280
#define NEXP   16384

typedef unsigned short bf16_t;
typedef short bf16x8 __attribute__((ext_vector_type(8)));
typedef float f32x4 __attribute__((ext_vector_type(4)));
typedef float f32x16 __attribute__((ext_vector_type(16)));
typedef unsigned u32x4 __attribute__((ext_vector_type(4)));
typedef unsigned u32x2 __attribute__((ext_vector_type(2)));
typedef long i64x2 __attribute__((ext_vector_type(2)));

#define WS_BAR      0ull
#define WS_MODV     16384ull
#define WS_WIN_T    (WS_MODV + 147456ull)
#define WS_QB_T     (WS_WIN_T + 2621440ull)
#define WS_KVB_T    (WS_QB_T + 589824ull)
#define WS_POOL_T   (WS_KVB_T + 524288ull)
#define WS_WOUT_T   (WS_POOL_T + 131072ull)
#define WS_CIN_T    (WS_WOUT_T + 2097152ull)
#define WS_COUT_T   (WS_CIN_T + 6291456ull)
#define WS_WQ_T     (WS_COUT_T + 2097152ull)
#define WS_KEYS     (WS_WQ_T + 4194304ull)
#define WS_UTAB     (WS_KEYS + 524288ull)
#define WS_VTAB     (WS_UTAB + 33554432ull)
#define WS_XQ8      (WS_VTAB + 33554432ull)
#define WS_SU       (WS_XQ8 + 33554432ull)
#define WS_SX       (WS_SU + 131072ull)
#define WS_SV       (WS_SX + 524288ull)
#define WS_A0       (WS_SX + 1048576ull)
#define WS_R        (WS_A0 + 68157440ull)
#define R_H0        0ull
#define R_HQN       (R_H0 + 85196800ull)
#define R_CKVN      (R_HQN + 25559040ull)
#define R_Q         (R_CKVN + 17039360ull)
#define R_K         (R_Q + 50331648ull)
#define R_VT        (R_K + 51118080ull)
#define R_END0      (R_VT + 34078720ull)
#define R_H1        0ull
#define R_Z         201326592ull
#define R_END1      (R_Z + 67108864ull)
#define WS_XS       (WS_R + (R_END1 > R_END0 ? R_END1 : R_END0))
#define WS_TOTAL    (WS_XS + 67108864ull)


struct Params {
    const float *x, *c, *ctx, *c_ctx, *mod_w, *mod_b, *norm_mix, *norm_ffn, *ab_w_in, *q_a_norm, *q_b_w, *kv_a_norm, *kv_b_w,
                *q_norm, *k_norm, *pool_w, *pool_scale, *ab_w_out, *c_w_in, *c_conv, *c_w_out, *peer_wq, *peer_keys, *peer_u, *peer_v;
    float* out;
    unsigned char* ws;
};

typedef float f32x2 __attribute__((ext_vector_type(2)));
typedef __bf16 bf16x2_t __attribute__((ext_vector_type(2)));
__device__ __forceinline__ unsigned cvt_pk_bf16(float lo, float hi) {
    const f32x2 v = {lo, hi}; const bf16x2_t b = __builtin_convertvector(v, bf16x2_t); return __builtin_bit_cast(unsigned, b);
}
__device__ __forceinline__ float bf_lo(unsigned u) { return __uint_as_float(u << 16); }
__device__ __forceinline__ float bf_hi(unsigned u) { return __uint_as_float(u & 0xffff0000u); }
__device__ __forceinline__ float bf2f(bf16_t b) { return __uint_as_float(((unsigned)b) << 16); }
#define LDS_HALF 75776
__device__ __forceinline__ int opaque_tid() { int t = threadIdx.x & 255; asm volatile("" : "+v"(t)); return t; }
__device__ __forceinline__ int vbid() { return (int)blockIdx.x * 2 + __builtin_amdgcn_readfirstlane((int)(threadIdx.x >> 8)); }
__device__ __forceinline__ int nvb() { return (int)gridDim.x * 2; }
__device__ __forceinline__ float wave_sum(float v) {
#pragma unroll
    for (int o = 32; o >= 1; o >>= 1) v += __shfl_xor(v, o);
    return v;
}

#define XB_TMO      128
#define XB_XCNT(j)  (256  + 64 * (j))
#define XB_XSUB(j)  (1280 + 64 * (j))
#define XB_XGEN(j)  (2304 + 64 * (j))
#define XB_TOP      3328
#define XB_TOPGEN   3392
#define XCD_BAR_WORDS 3456
#define XB_SPIN_CAP (1u << 25)
#define LAS __attribute__((address_space(3)))

__device__ __forceinline__ unsigned xb_ld(unsigned* p)              { return __hip_atomic_load(p, __ATOMIC_RELAXED, __HIP_MEMORY_SCOPE_AGENT); }
__device__ __forceinline__ unsigned xb_add(unsigned* p, unsigned v) { return __hip_atomic_fetch_add(p, v, __ATOMIC_RELAXED, __HIP_MEMORY_SCOPE_AGENT); }
__device__ __forceinline__ unsigned xb_xcc_id() { return (unsigned)__builtin_amdgcn_s_getreg((3 << 11) | 20) & 0xFu; }
#define XB_SPIN(cond, bar) do { unsigned _sp = 0; while (cond) { __builtin_amdgcn_s_sleep(1); \
    if ((++_sp & 255u) == 0u) { if (xb_ld(&(bar)[XB_TMO])) break; if (_sp > XB_SPIN_CAP) { atomicAdd(&(bar)[XB_TMO], 1u); break; } } } } while (0)

struct XcdBarrier { unsigned* bar; unsigned x; volatile LAS unsigned* st; };

__device__ __forceinline__ XcdBarrier xcd_barrier_post(unsigned* bar, volatile LAS unsigned* st) {
    XcdBarrier b; b.bar = bar; b.x = xb_xcc_id(); b.st = st;
    if (threadIdx.x == 0) st[2] = xb_add(&bar[XB_XCNT(b.x)], 1u);
    return b;
}
__device__ __forceinline__ void xcd_barrier_complete(unsigned* bar, unsigned x, unsigned& nloc, unsigned& nx) {
    const unsigned G = gridDim.x * gridDim.y * gridDim.z;
    unsigned sum, cnt, mine, sp = 0u;
    for (;;) {
        sum = 0u; cnt = 0u; mine = 0u;
#pragma unroll
        for (unsigned j = 0; j < 16; ++j) { const unsigned c = xb_ld(&bar[XB_XCNT(j)]); sum += c; cnt += (c > 0u) ? 1u : 0u; mine = (j == x) ? c : mine; }
        if (sum == G) break;
        __builtin_amdgcn_s_sleep(1);
        if ((++sp & 255u) == 0u) { if (xb_ld(&bar[XB_TMO])) break; if (sp > XB_SPIN_CAP) { atomicAdd(&bar[XB_TMO], 1u); break; } }
    }
    nloc = mine > 0u ? mine : 1u; nx = cnt > 0u ? cnt : 1u;
}
__device__ __forceinline__ void xcd_barrier(const XcdBarrier& b) {
    asm volatile("s_waitcnt vmcnt(0)" ::: "memory");
    __syncthreads();
    if (threadIdx.x == 0) {
        unsigned* bar = b.bar;
        __builtin_amdgcn_s_waitcnt(0);
        unsigned nloc = b.st[0], nx = b.st[1];
        if (nloc == 0u) { xcd_barrier_complete(bar, b.x, nloc, nx); b.st[0] = nloc; b.st[1] = nx; }
        const unsigned old = xb_add(&bar[XB_XSUB(b.x)], 1u);
        const unsigned gen = old / nloc;
        if (old + 1u == (gen + 1u) * nloc) {
            __builtin_amdgcn_fence(__ATOMIC_RELEASE, "agent");
            asm volatile("s_waitcnt vmcnt(0)" ::: "memory");
            const unsigned og = xb_add(&bar[XB_TOP], 1u);
            const unsigned tg = og / nx;
            if (og + 1u == (tg + 1u) * nx) xb_add(&bar[XB_TOPGEN], 1u);
            else XB_SPIN(xb_ld(&bar[XB_TOPGEN]) == tg, bar);
            __builtin_amdgcn_fence(__ATOMIC_ACQUIRE, "agent");
            xb_add(&bar[XB_XGEN(b.x)], 1u);
            asm volatile("s_waitcnt vmcnt(0)" ::: "memory");
        } else {
            XB_SPIN(xb_ld(&bar[XB_XGEN(b.x)]) == gen, bar);
            __builtin_amdgcn_fence(__ATOMIC_ACQUIRE, "agent");
            asm volatile("s_waitcnt vmcnt(0)" ::: "memory");
        }
    }
    __syncthreads();
}

#define LDS_BYTES (2 * 75776 + 16)
#define LDS_XB_OFF (2 * 75776)

__device__ __forceinline__ void p0_modvec(const Params& p, float* lds_f, int task) {
    const int tidx_ = opaque_tid();
    const int l = task / 384, cc = task % 384;
    const int tid = tidx_, lane = tid & 63, w = tid >> 6, col = lane & 15, rsub = lane >> 4;
    for (int i = tid; i < 3072; i += 256) {
        const int v = i >> 10, k = i & 1023;
        const float c = (v < 2) ? p.c[v * 1024 + k] : p.c_ctx[k];
        lds_f[i] = c / (1.f + __expf(-c));
    }
    __syncthreads();
    const float* W = p.mod_w + (size_t)l * 1024 * 6144 + cc * 16 + col;
    float a0 = 0.f, a1 = 0.f, a2 = 0.f;
    const int k0 = w * 256 + rsub;
#pragma unroll 16
    for (int m = 0; m < 64; ++m) {
        const int k = k0 + 4 * m;
        const float wv = W[(size_t)k * 6144];
        a0 += wv * lds_f[k]; a1 += wv * lds_f[1024 + k]; a2 += wv * lds_f[2048 + k];
    }
    a0 += __shfl_xor(a0, 16); a0 += __shfl_xor(a0, 32);
    a1 += __shfl_xor(a1, 16); a1 += __shfl_xor(a1, 32);
    a2 += __shfl_xor(a2, 16); a2 += __shfl_xor(a2, 32);
    float* red = lds_f + 3072;
    if (lane < 16) { red[(w * 3 + 0) * 16 + col] = a0; red[(w * 3 + 1) * 16 + col] = a1; red[(w * 3 + 2) * 16 + col] = a2; }
    __syncthreads();
    if (tid < 48) {
        const int v = tid >> 4, ln = tid & 15;
        const float sm_ = red[(0 * 3 + v) * 16 + ln] + red[(1 * 3 + v) * 16 + ln] + red[(2 * 3 + v) * 16 + ln] + red[(3 * 3 + v) * 16 + ln];
        const int cl = cc * 16 + ln;
        float* modv = (float*)(p.ws + WS_MODV);
        modv[(l * 3 + v) * 6144 + cl] = sm_ + p.mod_b[l * 6144 + cl];
    }
    __syncthreads();
}

struct TrD { const float* src; bf16_t* dst; int K, N; const float* kgain; };
__device__ __forceinline__ void p0_transpose_tile(const TrD d, int tile, float* lds_f) {
    const int tidx_ = opaque_tid();
    const int tilesK = d.K >> 6;
    const int tn = tile / tilesK, tk = tile % tilesK;
    const int n0 = tn * 64, k0 = tk * 64;
    const int tid = tidx_;
#pragma unroll
    for (int i = 0; i < 4; ++i) {
        const int r = (tid >> 4) + 16 * i, c4 = (tid & 15) * 4;
        f32x4 v = {0.f, 0.f, 0.f, 0.f};
        if (n0 + c4 < d.N) v = *(const f32x4*)(d.src + (size_t)(k0 + r) * d.N + n0 + c4);
        if (d.kgain) v = v * d.kgain[k0 + r];
        float* q = lds_f + r * 65 + c4;
        q[0] = v[0]; q[1] = v[1]; q[2] = v[2]; q[3] = v[3];
    }
    __syncthreads();
    {
        const int n = tid >> 2, kc = (tid & 3) * 16;
        unsigned w[8];
#pragma unroll
        for (int j = 0; j < 8; ++j) w[j] = cvt_pk_bf16(lds_f[(kc + 2 * j) * 65 + n], lds_f[(kc + 2 * j + 1) * 65 + n]);
        bf16_t* o = d.dst + (size_t)(n0 + n) * d.K + k0 + kc;
        *(u32x4*)o = (u32x4){w[0], w[1], w[2], w[3]};
        *(u32x4*)(o + 8) = (u32x4){w[4], w[5], w[6], w[7]};
    }
    __syncthreads();
}

__device__ __forceinline__ void cvt_flat(const float* src, bf16_t* dst, size_t n) {
    const int tidx_ = opaque_tid();
    const size_t nth = (size_t)nvb() * 256;
    for (size_t i = ((size_t)vbid() * 256 + tidx_) * 8; i < n; i += nth * 8) {
        const f32x4 a = *(const f32x4*)(src + i), b = *(const f32x4*)(src + i + 4);
        *(u32x4*)(dst + i) = (u32x4){cvt_pk_bf16(a[0], a[1]), cvt_pk_bf16(a[2], a[3]), cvt_pk_bf16(b[0], b[1]), cvt_pk_bf16(b[2], b[3])};
    }
}

__device__ __forceinline__ unsigned q4(float v) { int q = (int)rintf(v); q = q > 7 ? 7 : q; q = q < -8 ? -8 : q; return (unsigned)q & 0xfu; }
__device__ __forceinline__ void cvt_tab_i4(const float* src, unsigned char* dst, float* su) {
    const int tidx_ = opaque_tid();
    const int lane = tidx_ & 63, w = tidx_ >> 6;
    const int half = NEXP;
    for (int row = vbid() * 4 + w; row < half; row += nvb() * 4) {
        f32x4 v[2][4]; float am[2] = {0.f, 0.f}, sq[2] = {0.f, 0.f};
#pragma unroll
        for (int h = 0; h < 2; ++h) {
            const float* sr = src + (size_t)(row + h * half) * DM + lane * 16;
#pragma unroll
            for (int q = 0; q < 4; ++q) v[h][q] = *(const f32x4*)(sr + q * 4);
        }
#pragma unroll
        for (int h = 0; h < 2; ++h)
#pragma unroll
            for (int q = 0; q < 4; ++q) {
                am[h] = fmaxf(am[h], fmaxf(fmaxf(fabsf(v[h][q][0]), fabsf(v[h][q][1])), fmaxf(fabsf(v[h][q][2]), fabsf(v[h][q][3]))));
                sq[h] += v[h][q][0] * v[h][q][0] + v[h][q][1] * v[h][q][1] + v[h][q][2] * v[h][q][2] + v[h][q][3] * v[h][q][3];
            }
#pragma unroll
        for (int o = 32; o >= 1; o >>= 1) { am[0] = fmaxf(am[0], __shfl_xor(am[0], o)); am[1] = fmaxf(am[1], __shfl_xor(am[1], o)); sq[0] += __shfl_xor(sq[0], o); sq[1] += __shfl_xor(sq[1], o); }
#pragma unroll
        for (int h = 0; h < 2; ++h) {
            const float step = fminf(am[h] * (1.0f / 7.0f), 0.3352f * sqrtf(sq[h] * (1.0f / 1024.0f)));
            const float sc = step > 0.f ? 1.0f / step : 0.f;
            u32x2 o2;
#pragma unroll
            for (int d = 0; d < 2; ++d) {
                const f32x4 a = v[h][2 * d], b = v[h][2 * d + 1];
                o2[d] = q4(a[0] * sc) | (q4(a[1] * sc) << 4) | (q4(a[2] * sc) << 8) | (q4(a[3] * sc) << 12) | (q4(b[0] * sc) << 16) | (q4(b[1] * sc) << 20) | (q4(b[2] * sc) << 24) | (q4(b[3] * sc) << 28);
            }
            *(u32x2*)(dst + (((size_t)h * 4 + (lane >> 4)) * NEXP + row) * 128 + (lane & 15) * 8) = o2;
            if (lane == 0) su[row + h * half] = step;
        }
    }
}

__device__ __forceinline__ void cvt_tab_fp4(const float* src, unsigned char* dst, float* sv) {
    const int tidx_ = opaque_tid();
    const int lane = tidx_ & 63, w = tidx_ >> 6;
    const int half = NEXP;
    for (int row = vbid() * 4 + w; row < half; row += nvb() * 4) {
        f32x4 v[2][4]; float am[2] = {0.f, 0.f}, sq[2] = {0.f, 0.f};
#pragma unroll
        for (int h = 0; h < 2; ++h) {
            const float* sr = src + (size_t)(row + h * half) * DM + lane * 16;
#pragma unroll
            for (int q = 0; q < 4; ++q) v[h][q] = *(const f32x4*)(sr + q * 4);
        }
#pragma unroll
        for (int h = 0; h < 2; ++h)
#pragma unroll
            for (int q = 0; q < 4; ++q) {
                am[h] = fmaxf(am[h], fmaxf(fmaxf(fabsf(v[h][q][0]), fabsf(v[h][q][1])), fmaxf(fabsf(v[h][q][2]), fabsf(v[h][q][3]))));
                sq[h] += v[h][q][0] * v[h][q][0] + v[h][q][1] * v[h][q][1] + v[h][q][2] * v[h][q][2] + v[h][q][3] * v[h][q][3];
            }
#pragma unroll
        for (int o = 32; o >= 1; o >>= 1) { am[0] = fmaxf(am[0], __shfl_xor(am[0], o)); am[1] = fmaxf(am[1], __shfl_xor(am[1], o)); sq[0] += __shfl_xor(sq[0], o); sq[1] += __shfl_xor(sq[1], o); }
#pragma unroll
        for (int h = 0; h < 2; ++h) {
            const float unit = fminf(am[h] * (1.0f / 6.0f), 0.49f * sqrtf(sq[h] * (1.0f / 1024.0f)));
            const float sc = unit > 0.f ? 1.0f / unit : 0.f;
            unsigned o0 = 0u, o1 = 0u;
            o0 = __builtin_amdgcn_cvt_scalef32_pk_fp4_f32(o0, v[h][0][0] * sc, v[h][0][1] * sc, 1.0f, 0);
            o0 = __builtin_amdgcn_cvt_scalef32_pk_fp4_f32(o0, v[h][0][2] * sc, v[h][0][3] * sc, 1.0f, 1);
            o0 = __builtin_amdgcn_cvt_scalef32_pk_fp4_f32(o0, v[h][1][0] * sc, v[h][1][1] * sc, 1.0f, 2);
            o0 = __builtin_amdgcn_cvt_scalef32_pk_fp4_f32(o0, v[h][1][2] * sc, v[h][1][3] * sc, 1.0f, 3);
            o1 = __builtin_amdgcn_cvt_scalef32_pk_fp4_f32(o1, v[h][2][0] * sc, v[h][2][1] * sc, 1.0f, 0);
            o1 = __builtin_amdgcn_cvt_scalef32_pk_fp4_f32(o1, v[h][2][2] * sc, v[h][2][3] * sc, 1.0f, 1);
            o1 = __builtin_amdgcn_cvt_scalef32_pk_fp4_f32(o1, v[h][3][0] * sc, v[h][3][1] * sc, 1.0f, 2);
            o1 = __builtin_amdgcn_cvt_scalef32_pk_fp4_f32(o1, v[h][3][2] * sc, v[h][3][3] * sc, 1.0f, 3);
            *(u32x2*)(dst + (((size_t)h * 4 + (lane >> 4)) * NEXP + row) * 128 + (lane & 15) * 8) = (u32x2){o0, o1};
            if (lane == 0) sv[row + h * half] = unit;
        }
    }
}

__device__ __forceinline__ void phase0(const Params& p, unsigned char* lds) {
    float* lds_f = (float*)lds;
    for (int t = vbid(); t < 768; t += nvb()) p0_modvec(p, lds_f, t);
    unsigned char* ws = p.ws;
#define TRANSPOSE(SRC, DSTOFF, KK, NN, NPAD) TRANSPOSE_G(SRC, DSTOFF, KK, NN, NPAD, nullptr)
#define TRANSPOSE_G(SRC, DSTOFF, KK, NN, NPAD, KG) do { const TrD d_{(SRC), (bf16_t*)(ws + (DSTOFF)), (KK), (NN), (KG)}; \
        for (int t = vbid(); t < ((NPAD) / 64) * ((KK) / 64); t += nvb()) p0_transpose_tile(d_, t, lds_f); } while (0)
    TRANSPOSE(p.ab_w_in, WS_WIN_T, 1024, 1184, 1280);
    TRANSPOSE_G(p.q_b_w, WS_QB_T, 384, 768, 768, p.q_a_norm);
    TRANSPOSE_G(p.kv_b_w, WS_KVB_T, 256, 1024, 1024, p.kv_a_norm);
    for (int g = 0; g < 4; ++g) TRANSPOSE(p.pool_w + g * 128 * 128, WS_POOL_T + (unsigned long long)g * 128 * 128 * 2, 128, 128, 128);
    TRANSPOSE(p.ab_w_out, WS_WOUT_T, 1024, 1024, 1024);
    TRANSPOSE(p.c_w_in, WS_CIN_T, 1024, 3072, 3072);
    TRANSPOSE(p.c_w_out, WS_COUT_T, 1024, 1024, 1024);
    TRANSPOSE(p.peer_wq, WS_WQ_T, 1024, 1024, 1024);
    TRANSPOSE(p.peer_wq + 1024 * 1024, WS_WQ_T + 2097152ull, 1024, 1024, 1024);
#undef TRANSPOSE
#undef TRANSPOSE_G
    cvt_flat(p.peer_keys, (bf16_t*)(p.ws + WS_KEYS), 262144);
    cvt_tab_i4(p.peer_u, p.ws + WS_UTAB, (float*)(p.ws + WS_SU));
    cvt_tab_fp4(p.peer_v, p.ws + WS_VTAB, (float*)(p.ws + WS_SV));
}

template <bool XBF>
__device__ __forceinline__ void rowmod_phase(const Params& p, const void* src_lat_, const float* src_ctx, const float* gain, int layer, int shift_idx, bf16_t* dst, int nrows, unsigned char* xq8) {
    const int tidx_ = opaque_tid();
    const int lane = tidx_ & 63, w = tidx_ >> 6;
    const float* modv = (const float*)(p.ws + WS_MODV) + (size_t)layer * 3 * 6144;
    const int stride = nvb() * 4;
    int row = vbid() * 4 + w;
    if (row >= nrows) return;
    const int rlast = row + ((nrows - 1 - row) / stride) * stride;
    f32x4 x[4], xn[4];
#define RM_LOAD(R, X) do { \
        if (XBF) { const bf16_t* src = (const bf16_t*)src_lat_ + (size_t)(R) * DM;            \
            _Pragma("unroll") for (int i = 0; i < 4; ++i) { const u32x2 u = *(const u32x2*)(src + i * 256 + lane * 4); X[i] = (f32x4){bf_lo(u[0]), bf_hi(u[0]), bf_lo(u[1]), bf_hi(u[1])}; } \
        } else { const float* src = ((R) < NTOK) ? (const float*)src_lat_ + (size_t)(R) * DM : src_ctx + (size_t)((R) - NTOK) * DM; \
            _Pragma("unroll") for (int i = 0; i < 4; ++i) X[i] = *(const f32x4*)(src + i * 256 + lane * 4); } } while (0)
    RM_LOAD(row, x);
    for (;;) {
        const int nrow = row + stride, nr = nrow < rlast ? nrow : rlast;
        RM_LOAD(nr, xn);
        const int v = (row < NTOK) ? (row >> 14) : 2;
        const float* sh = modv + v * 6144 + shift_idx * 1024;
        const float* sc = sh + 1024;
        float ss = 0.f;
#pragma unroll
        for (int i = 0; i < 4; ++i) ss += x[i][0] * x[i][0] + x[i][1] * x[i][1] + x[i][2] * x[i][2] + x[i][3] * x[i][3];
        ss = wave_sum(ss);
        const float rstd = rsqrtf(ss * (1.0f / 1024.0f) + 1e-6f);
#pragma unroll
        for (int i = 0; i < 4; ++i) {
            const int d0 = i * 256 + lane * 4;
            const f32x4 g = *(const f32x4*)(gain + d0), s = *(const f32x4*)(sh + d0), c = *(const f32x4*)(sc + d0);
            float y[4];
#pragma unroll
            for (int j = 0; j < 4; ++j) y[j] = x[i][j] * rstd * g[j] * (1.f + c[j]) + s[j];
            *(u32x2*)(dst + (size_t)row * DM + d0) = (u32x2){cvt_pk_bf16(y[0], y[1]), cvt_pk_bf16(y[2], y[3])};
            if (xq8) {
                float am = fmaxf(fmaxf(fabsf(y[0]), fabsf(y[1])), fmaxf(fabsf(y[2]), fabsf(y[3])));
#pragma unroll
                for (int o = 32; o >= 1; o >>= 1) am = fmaxf(am, __shfl_xor(am, o));
                const float scq = am > 0.f ? 119.0f / am : 0.f;
                unsigned nl = 0u, nh = 0u;
#pragma unroll
                for (int j = 0; j < 4; ++j) { int q = (int)rintf(y[j] * scq); q = q > 119 ? 119 : q; q = q < -119 ? -119 : q; nl |= ((unsigned)q & 15u) << (4 * j); nh |= ((unsigned)((q + 8) >> 4) & 15u) << (4 * j); }
                const bool odd_ = (lane & 1) != 0;
                const unsigned got = (unsigned)__builtin_amdgcn_update_dpp(0, (int)(odd_ ? nl : nh), 0xB1, 0xf, 0xf, true);
                const unsigned word = odd_ ? (got | (nh << 16)) : (nl | (got << 16));
                *(unsigned*)(xq8 + ((size_t)i * NTOK + row) * 256 + (lane >> 3) * 32 + (odd_ ? 16 : 0) + ((lane >> 1) & 3) * 4) = word;
                if (lane == 0) ((float*)(p.ws + WS_SX))[(size_t)i * NTOK + row] = am * (1.0f / 119.0f);
            }
        }
        if (nrow > rlast) break;
        row = nrow;
#pragma unroll
        for (int i = 0; i < 4; ++i) x[i] = xn[i];
    }
#undef RM_LOAD
}

#define EPI_BF16   0
#define EPI_RESID  1
#define EPI_RESIDB 2
struct GemmArgs {
    const bf16_t* A; int lda;
    const bf16_t* Bt; int ldb;
    int K;
    bf16_t* C; int ldc; const float* colscale;
    const float* xin; bf16_t* xs; const float* gate; int gate_bstride;
};

__device__ __forceinline__ int swz(int row, int ch) { return row * 128 + ((ch ^ ((row >> 1) & 7)) << 4); }

template <int EPI, bool NORM = false>
__device__ __forceinline__ void gemm_tile(const GemmArgs& g, int tm, int tn, unsigned char* lds) {
    const int tidx_ = opaque_tid();
    const int tid = tidx_, lane = tid & 63, w = __builtin_amdgcn_readfirstlane(tid >> 6);
    const int wm = w >> 1, wn = w & 1;
    const int lr = lane & 15, lg = lane >> 4;
    const bf16_t* Ag = g.A + (size_t)(tm * 128) * g.lda;
    const bf16_t* Bg = g.Bt + (size_t)(tn * 128) * g.ldb;
    f32x4 acc[4][4];
#pragma unroll
    for (int i = 0; i < 4; ++i)
#pragma unroll
        for (int j = 0; j < 4; ++j) acc[i][j] = (f32x4){0.f, 0.f, 0.f, 0.f};
    float ssq[4] = {0.f, 0.f, 0.f, 0.f};
    const bf16_t* pa_[4]; const bf16_t* pb_[4];
#pragma unroll
    for (int i = 0; i < 4; ++i) {
        const int c = tid + 256 * i, row = c >> 3, ch = (c & 7) ^ ((row >> 1) & 7);
        pa_[i] = Ag + (size_t)row * g.lda + ch * 8;
        pb_[i] = Bg + (size_t)row * g.ldb + ch * 8;
    }
    const int nk = g.K >> 6;
#define GEMM_ISSUE(KT, BUF) do { _Pragma("unroll") for (int i = 0; i < 4; ++i) { \
        __builtin_amdgcn_global_load_lds((const __attribute__((address_space(1))) void*)(pa_[i] + (KT) * 64), (LAS void*)(lds + (BUF) * 32768 + (w * 64 + 256 * i) * 16), 16, 0, 0); \
        __builtin_amdgcn_global_load_lds((const __attribute__((address_space(1))) void*)(pb_[i] + (KT) * 64), (LAS void*)(lds + (BUF) * 32768 + 16384 + (w * 64 + 256 * i) * 16), 16, 0, 0); } } while (0)
    GEMM_ISSUE(0, 0);
    for (int kt = 0; kt < nk; ++kt) {
        const int cur = kt & 1;
        asm volatile("s_waitcnt vmcnt(0)" ::: "memory");
        __syncthreads();
        if (kt + 1 < nk) GEMM_ISSUE(kt + 1, cur ^ 1);
        const unsigned char* sAc = lds + cur * 32768; const unsigned char* sBc = sAc + 16384;
#pragma unroll
        for (int ks = 0; ks < 2; ++ks) {
            bf16x8 af[4], bfr[4];
#pragma unroll
            for (int i = 0; i < 4; ++i) {
                af[i]  = *(const bf16x8*)(sAc + swz(wm * 64 + i * 16 + lr, ks * 4 + lg));
                bfr[i] = *(const bf16x8*)(sBc + swz(wn * 64 + i * 16 + lr, ks * 4 + lg));
            }
            if (NORM) {
#pragma unroll
                for (int i = 0; i < 4; ++i) {
                    const u32x4 u_ = __builtin_bit_cast(u32x4, af[i]);
                    const unsigned u0 = u_[0], u1 = u_[1], u2 = u_[2], u3 = u_[3];
                    ssq[i] = __builtin_amdgcn_fdot2_f32_bf16(__builtin_bit_cast(bf16x2_t, u0), __builtin_bit_cast(bf16x2_t, u0), ssq[i], false);
                    ssq[i] = __builtin_amdgcn_fdot2_f32_bf16(__builtin_bit_cast(bf16x2_t, u1), __builtin_bit_cast(bf16x2_t, u1), ssq[i], false);
                    ssq[i] = __builtin_amdgcn_fdot2_f32_bf16(__builtin_bit_cast(bf16x2_t, u2), __builtin_bit_cast(bf16x2_t, u2), ssq[i], false);
                    ssq[i] = __builtin_amdgcn_fdot2_f32_bf16(__builtin_bit_cast(bf16x2_t, u3), __builtin_bit_cast(bf16x2_t, u3), ssq[i], false);
                }
            }
#pragma unroll
            for (int i = 0; i < 4; ++i)
#pragma unroll
                for (int j = 0; j < 4; ++j) acc[i][j] = __builtin_amdgcn_mfma_f32_16x16x32_bf16(bfr[j], af[i], acc[i][j], 0, 0, 0);
        }
    }
#undef GEMM_ISSUE
    if (NORM) {
#pragma unroll
        for (int i = 0; i < 4; ++i) {
            float t_ = ssq[i]; t_ += __shfl_xor(t_, 16); t_ += __shfl_xor(t_, 32);
            const float rs_ = rsqrtf(t_ / (float)g.K + 1e-6f);
#pragma unroll
            for (int j = 0; j < 4; ++j) acc[i][j] = acc[i][j] * rs_;
        }
    }
    __syncthreads();
#pragma unroll
    for (int i = 0; i < 4; ++i) {
        const int row = tm * 128 + wm * 64 + i * 16 + lr;
#pragma unroll
        for (int j = 0; j < 4; ++j) {
            const int col = tn * 128 + wn * 64 + j * 16 + lg * 4;
            f32x4 v = acc[i][j];
            if (EPI == EPI_BF16) {
                if (g.colscale) { const f32x4 s = *(const f32x4*)(g.colscale + col); v = v * s; }
                *(u32x2*)(g.C + (size_t)row * g.ldc + col) = (u32x2){cvt_pk_bf16(v[0], v[1]), cvt_pk_bf16(v[2], v[3])};
            } else {
                const f32x4 gt = *(const f32x4*)(g.gate + (size_t)(row >> 14) * g.gate_bstride + col);
                f32x4 xi;
                if (EPI == EPI_RESID) xi = *(const f32x4*)(g.xin + (size_t)row * DM + col);
                else { const u32x2 u = *(const u32x2*)(g.xs + (size_t)row * DM + col); xi = (f32x4){bf_lo(u[0]), bf_hi(u[0]), bf_lo(u[1]), bf_hi(u[1])}; }
                const f32x4 xo = xi + gt * v;
                *(u32x2*)(g.xs + (size_t)row * DM + col) = (u32x2){cvt_pk_bf16(xo[0], xo[1]), cvt_pk_bf16(xo[2], xo[3])};
            }
        }
    }
}

struct SliceMap { int j, rank, nb, rank4, nb4; };
__device__ __forceinline__ SliceMap peer_slice_map(const XcdBarrier& xb) {
    const int half_ = __builtin_amdgcn_readfirstlane((int)(threadIdx.x >> 8));
    SliceMap m; m.j = (int)blockIdx.x & 7; m.rank = ((int)blockIdx.x >> 3) * 2 + half_; m.nb = (((int)gridDim.x - m.j + 7) >> 3) * 2;
    int nbp = (((int)gridDim.x - (m.j ^ 4) + 7) >> 3) * 2;
#if !USE_CG
    unsigned sum = 0u; bool ok = true; unsigned mine = 0u, theirs = 0u;
#pragma unroll
    for (unsigned q = 0; q < 8; ++q) { const unsigned c = xb_ld(&xb.bar[XB_XCNT(q)]); sum += c; ok = ok && (c > 0u); mine = (q == xb.x) ? c : mine; theirs = (q == (xb.x ^ 4u)) ? c : theirs; }
    if (ok && sum == gridDim.x && xb.x < 8u) { m.j = (int)xb.x; m.rank = (int)xb.st[2] * 2 + half_; m.nb = (int)mine * 2; nbp = (int)theirs * 2; }
#endif
    m.rank4 = (m.j < 4) ? m.rank : nbp + m.rank; m.nb4 = m.nb + nbp;
    m.j = __builtin_amdgcn_readfirstlane(m.j); m.rank = __builtin_amdgcn_readfirstlane(m.rank); m.nb = __builtin_amdgcn_readfirstlane(m.nb);
    m.rank4 = __builtin_amdgcn_readfirstlane(m.rank4); m.nb4 = __builtin_amdgcn_readfirstlane(m.nb4);
    return m;
}
template <int EPI, bool NORM = false>
__device__ __forceinline__ void gemm_phase(const GemmArgs& g, const SliceMap sm, int ntm, int ntn, unsigned char* lds) {
    const int np = (ntm - sm.j + 7) >> 3, nt = np * ntn;
    for (int u = sm.rank; u < nt; u += sm.nb) gemm_tile<EPI, NORM>(g, sm.j + 8 * (u / ntn), u % ntn, lds);
}


#define G8_HT 8192
__device__ __forceinline__ int g8_lds_byte(int r, int c) { const int st = (r >> 4) * 2 + (c >> 5), rr = r & 15, cc = c & 31, ob = rr * 64 + cc * 2; return st * 1024 + (ob ^ (((ob >> 9) & 1) << 5)); }
__device__ __forceinline__ void g8_stage_rc(int b, int& R, int& C) { const int st = b / 1024, sb = b % 1024, swz = sb ^ (((sb >> 9) & 1) << 5); R = (st >> 1) * 16 + swz / 64; C = (st & 1) * 32 + (swz % 64) / 2; }
template <int EPI, bool NORM>
__device__ __forceinline__ void gemm8_tile(const GemmArgs& g, int tm, int tn, unsigned char* lds_all) {
    bf16_t* shm = (bf16_t*)lds_all;
    int tidx = threadIdx.x; asm volatile("" : "+v"(tidx));
    const int wid = __builtin_amdgcn_readfirstlane(tidx >> 6), lane = tidx & 63, wr = wid >> 2, wc = wid & 3, fr = lane & 15, fq = lane >> 4;
    const int K = g.K, nt = K >> 6;
    const bf16_t* A = g.A; const bf16_t* Bt = g.Bt;
    const long lda = g.lda, ldb = g.ldb;
    const int brow = tm * 256, bcol = tn * 256;
#define G8_SA(b, h) (shm + ((b) * 2 + (h)) * G8_HT)
#define G8_SB(b, h) (shm + (4 + (b) * 2 + (h)) * G8_HT)
    int offA_[2], offB_[2];
#pragma unroll
    for (int i_ = 0; i_ < 2; ++i_) { int r_, c_; g8_stage_rc(tidx * 16 + i_ * 8192, r_, c_); offA_[i_] = r_ * (int)lda + c_; offB_[i_] = r_ * (int)ldb + c_; }
#define G8_STAGE(P, BASE, LD, OFF, br, kt) do { const bf16_t* base_ = (BASE) + (long)(br) * (LD) + (long)(kt) * 64;        \
        _Pragma("unroll") for (int i_ = 0; i_ < 2; ++i_) \
            __builtin_amdgcn_global_load_lds((const __attribute__((address_space(1))) void*)(base_ + OFF[i_]), (LAS void*)((unsigned char*)(P) + (wid * 1024 + i_ * 8192)), 16, 0, 0); } while (0)
#define G8_LDA(dst, b, h) do { _Pragma("unroll") for (int m = 0; m < 4; ++m) _Pragma("unroll") for (int k = 0; k < 2; ++k) \
        dst[m][k] = *(const bf16x8*)((const unsigned char*)G8_SA(b, h) + g8_lds_byte(wr * 64 + m * 16 + fr, k * 32 + fq * 8)); \
        if (NORM) { _Pragma("unroll") for (int m = 0; m < 4; ++m) _Pragma("unroll") for (int k = 0; k < 2; ++k) { const u32x4 u_ = __builtin_bit_cast(u32x4, dst[m][k]); \
            const unsigned u0 = u_[0], u1 = u_[1], u2 = u_[2], u3 = u_[3]; \
            ssq[h][m] = __builtin_amdgcn_fdot2_f32_bf16(__builtin_bit_cast(bf16x2_t, u0), __builtin_bit_cast(bf16x2_t, u0), ssq[h][m], false); \
            ssq[h][m] = __builtin_amdgcn_fdot2_f32_bf16(__builtin_bit_cast(bf16x2_t, u1), __builtin_bit_cast(bf16x2_t, u1), ssq[h][m], false); \
            ssq[h][m] = __builtin_amdgcn_fdot2_f32_bf16(__builtin_bit_cast(bf16x2_t, u2), __builtin_bit_cast(bf16x2_t, u2), ssq[h][m], false); \
            ssq[h][m] = __builtin_amdgcn_fdot2_f32_bf16(__builtin_bit_cast(bf16x2_t, u3), __builtin_bit_cast(bf16x2_t, u3), ssq[h][m], false); } } } while (0)
#define G8_LDB(dst, b, h) do { _Pragma("unroll") for (int n = 0; n < 2; ++n) _Pragma("unroll") for (int k = 0; k < 2; ++k) \
        dst[n][k] = *(const bf16x8*)((const unsigned char*)G8_SB(b, h) + g8_lds_byte(wc * 32 + n * 16 + fr, k * 32 + fq * 8)); } while (0)
#define G8_MMA(ai, bj, At_, Bt_) do { __builtin_amdgcn_s_setprio(1); \
        _Pragma("unroll") for (int m = 0; m < 4; ++m) _Pragma("unroll") for (int n = 0; n < 2; ++n) _Pragma("unroll") for (int k = 0; k < 2; ++k) \
            acc[ai][bj][m][n] = __builtin_amdgcn_mfma_f32_16x16x32_bf16(Bt_[n][k], At_[m][k], acc[ai][bj][m][n], 0, 0, 0); \
        __builtin_amdgcn_s_setprio(0); } while (0)
#define G8_WAIT_V(n) asm volatile("s_waitcnt vmcnt(" #n ")" ::: "memory")
#define G8_WAIT_L(n) asm volatile("s_waitcnt lgkmcnt(" #n ")" ::: "memory")
#define G8_BAR __builtin_amdgcn_s_barrier()
#define G8_SCHED __builtin_amdgcn_sched_barrier(0)
    f32x4 acc[2][2][4][2];
#pragma unroll
    for (int a = 0; a < 2; ++a)
#pragma unroll
        for (int b = 0; b < 2; ++b)
#pragma unroll
            for (int m = 0; m < 4; ++m)
#pragma unroll
                for (int n = 0; n < 2; ++n) acc[a][b][m][n] = (f32x4){0.f, 0.f, 0.f, 0.f};
    float ssq[2][4] = {{0.f, 0.f, 0.f, 0.f}, {0.f, 0.f, 0.f, 0.f}};
    bf16x8 At[4][2], B0[2][2], B1[2][2];
    G8_WAIT_V(0);
    __syncthreads();
    G8_STAGE(G8_SB(0, 0), Bt, ldb, offB_, bcol, 0); G8_STAGE(G8_SA(0, 0), A, lda, offA_, brow, 0);
    G8_STAGE(G8_SB(0, 1), Bt, ldb, offB_, bcol + 128, 0); G8_STAGE(G8_SA(0, 1), A, lda, offA_, brow + 128, 0);
    if (wr == 1) G8_BAR;
    G8_WAIT_V(4); G8_BAR;
    G8_STAGE(G8_SB(1, 0), Bt, ldb, offB_, bcol, 1); G8_STAGE(G8_SA(1, 0), A, lda, offA_, brow, 1); G8_STAGE(G8_SB(1, 1), Bt, ldb, offB_, bcol + 128, 1);
    G8_WAIT_V(6); G8_BAR;
    for (int t = 0; t < nt - 2; t += 2) {
        G8_LDB(B0, 0, 0); G8_SCHED; G8_LDA(At, 0, 0); G8_STAGE(G8_SA(1, 1), A, lda, offA_, brow + 128, t + 1);
        G8_WAIT_L(8); G8_BAR; G8_WAIT_L(0); G8_MMA(0, 0, At, B0); G8_BAR; G8_SCHED;
        G8_LDB(B1, 0, 1); G8_STAGE(G8_SB(0, 0), Bt, ldb, offB_, bcol, t + 2);
        G8_BAR; G8_WAIT_L(0); G8_MMA(0, 1, At, B1); G8_BAR;
        G8_LDA(At, 0, 1); G8_STAGE(G8_SA(0, 0), A, lda, offA_, brow, t + 2);
        G8_BAR; G8_WAIT_L(0); G8_MMA(1, 0, At, B0); G8_BAR; G8_SCHED;
        G8_STAGE(G8_SB(0, 1), Bt, ldb, offB_, bcol + 128, t + 2);
        G8_WAIT_V(6); G8_BAR; G8_MMA(1, 1, At, B1); G8_BAR;
        G8_LDB(B0, 1, 0); G8_SCHED; G8_LDA(At, 1, 0); G8_STAGE(G8_SA(0, 1), A, lda, offA_, brow + 128, t + 2);
        G8_WAIT_L(8); G8_BAR; G8_WAIT_L(0); G8_MMA(0, 0, At, B0); G8_BAR; G8_SCHED;
        G8_LDB(B1, 1, 1); G8_STAGE(G8_SB(1, 0), Bt, ldb, offB_, bcol, t + 3);
        G8_BAR; G8_WAIT_L(0); G8_MMA(0, 1, At, B1); G8_BAR;
        G8_LDA(At, 1, 1); G8_STAGE(G8_SA(1, 0), A, lda, offA_, brow, t + 3);
        G8_BAR; G8_WAIT_L(0); G8_MMA(1, 0, At, B0); G8_BAR; G8_SCHED;
        G8_STAGE(G8_SB(1, 1), Bt, ldb, offB_, bcol + 128, t + 3);
        G8_WAIT_V(6); G8_BAR; G8_MMA(1, 1, At, B1); G8_BAR;
    }
    {
        G8_LDB(B0, 0, 0); G8_LDA(At, 0, 0); G8_STAGE(G8_SA(1, 1), A, lda, offA_, brow + 128, nt - 1);
        G8_BAR; G8_WAIT_L(0); G8_MMA(0, 0, At, B0); G8_BAR;
        G8_LDB(B1, 0, 1); G8_BAR; G8_WAIT_L(0); G8_MMA(0, 1, At, B1); G8_BAR;
        G8_LDA(At, 0, 1); G8_WAIT_V(4); G8_BAR; G8_WAIT_L(0); G8_MMA(1, 0, At, B0); G8_MMA(1, 1, At, B1); G8_BAR;
    }
    {
        G8_LDB(B0, 1, 0); G8_LDA(At, 1, 0); G8_WAIT_V(2); G8_BAR; G8_WAIT_L(0); G8_MMA(0, 0, At, B0); G8_BAR;
        G8_LDB(B1, 1, 1); G8_WAIT_V(0); G8_BAR; G8_WAIT_L(0); G8_MMA(0, 1, At, B1); G8_BAR;
        G8_LDA(At, 1, 1); G8_BAR; G8_WAIT_L(0); G8_MMA(1, 0, At, B0); G8_MMA(1, 1, At, B1); G8_BAR;
    }
    if (wr == 0) G8_BAR;
#pragma unroll
    for (int ai = 0; ai < 2; ++ai)
#pragma unroll
        for (int m = 0; m < 4; ++m) {
            const int row = brow + ai * 128 + wr * 64 + m * 16 + fr;
            float rs_ = 1.f;
            if (NORM) { float t_ = ssq[ai][m]; t_ += __shfl_xor(t_, 16); t_ += __shfl_xor(t_, 32); rs_ = rsqrtf(t_ / (float)K + 1e-6f); }
#pragma unroll
            for (int bj = 0; bj < 2; ++bj)
#pragma unroll
                for (int n = 0; n < 2; ++n) {
                    const int col = bcol + bj * 128 + wc * 32 + n * 16 + fq * 4;
                    f32x4 v = acc[ai][bj][m][n];
                    if (NORM) v = v * rs_;
                    if (EPI == EPI_BF16) {
                        if (g.colscale) { const f32x4 sc_ = *(const f32x4*)(g.colscale + col); v = v * sc_; }
                        *(u32x2*)(g.C + (size_t)row * g.ldc + col) = (u32x2){cvt_pk_bf16(v[0], v[1]), cvt_pk_bf16(v[2], v[3])};
                    } else {
                        const f32x4 gt = *(const f32x4*)(g.gate + (size_t)(row >> 14) * g.gate_bstride + col);
                        f32x4 xi;
                        if (EPI == EPI_RESID) xi = *(const f32x4*)(g.xin + (size_t)row * DM + col);
                        else { const u32x2 u = *(const u32x2*)(g.xs + (size_t)row * DM + col); xi = (f32x4){bf_lo(u[0]), bf_hi(u[0]), bf_lo(u[1]), bf_hi(u[1])}; }
                        const f32x4 xo = xi + gt * v;
                        *(u32x2*)(g.xs + (size_t)row * DM + col) = (u32x2){cvt_pk_bf16(xo[0], xo[1]), cvt_pk_bf16(xo[2], xo[3])};
                    }
                }
        }
#undef G8_SA
#undef G8_SB
#undef G8_STAGE
#undef G8_LDA
#undef G8_LDB
#undef G8_MMA
#undef G8_WAIT_V
#undef G8_WAIT_L
#undef G8_BAR
#undef G8_SCHED
}
struct SliceMap8 { int j, rank, nb; };
template <int EPI, bool NORM>
__device__ __forceinline__ void gemm8_phase(const GemmArgs& g, const SliceMap8 s8, int ntm, int ntn, unsigned char* lds_all) {
    const int np = (ntm - s8.j + 7) >> 3, nt = np * ntn;
    for (int u = s8.rank; u < nt; u += s8.nb) gemm8_tile<EPI, NORM>(g, s8.j + 8 * (u / ntn), u % ntn, lds_all);
}
__device__ __forceinline__ void latent_norm_phase(const Params& p) {
    const int tidx_ = opaque_tid();
    const int lane = tidx_ & 63, w = tidx_ >> 6;
    const bf16_t* h0 = (const bf16_t*)(p.ws + WS_R + R_H0);
    bf16_t* hqn = (bf16_t*)(p.ws + WS_R + R_HQN);
    bf16_t* ckvn = (bf16_t*)(p.ws + WS_R + R_CKVN);
    for (int row = vbid() * 4 + w; row < MROWS; row += nvb() * 4) {
        const bf16_t* hr = h0 + (size_t)row * H0LD;
        {
            const unsigned* s = (const unsigned*)(hr + lane * 6);
            const unsigned a = s[0], b = s[1], c = s[2];
            float v[6] = {bf_lo(a), bf_hi(a), bf_lo(b), bf_hi(b), bf_lo(c), bf_hi(c)};
            float ss = 0.f;
#pragma unroll
            for (int j = 0; j < 6; ++j) ss += v[j] * v[j];
            ss = wave_sum(ss);
            const float rstd = rsqrtf(ss * (1.0f / 384.0f) + 1e-6f);
            const float* gn = p.q_a_norm + lane * 6;
            unsigned* o = (unsigned*)(hqn + (size_t)row * 384 + lane * 6);
            o[0] = cvt_pk_bf16(v[0] * rstd * gn[0], v[1] * rstd * gn[1]);
            o[1] = cvt_pk_bf16(v[2] * rstd * gn[2], v[3] * rstd * gn[3]);
            o[2] = cvt_pk_bf16(v[4] * rstd * gn[4], v[5] * rstd * gn[5]);
        }
        {
            const u32x2 s = *(const u32x2*)(hr + 384 + lane * 4);
            float v[4] = {bf_lo(s[0]), bf_hi(s[0]), bf_lo(s[1]), bf_hi(s[1])};
            float ss = v[0] * v[0] + v[1] * v[1] + v[2] * v[2] + v[3] * v[3];
            ss = wave_sum(ss);
            const float rstd = rsqrtf(ss * (1.0f / 256.0f) + 1e-6f);
            const float* gn = p.kv_a_norm + lane * 4;
            *(u32x2*)(ckvn + (size_t)row * 256 + lane * 4) = (u32x2){cvt_pk_bf16(v[0] * rstd * gn[0], v[1] * rstd * gn[1]), cvt_pk_bf16(v[2] * rstd * gn[2], v[3] * rstd * gn[3])};
        }
    }
}

__device__ __forceinline__ void rope32(float* v  , int t) {
    const float inv[8] = {1.0f, 0.31622776601683794f, 0.1f, 0.031622776601683794f, 0.01f, 0.0031622776601683794f, 0.001f, 0.00031622776601683794f};
    const float pos[2] = {(float)(t >> 6), (float)(t & 63)};
#pragma unroll
    for (int a = 0; a < 2; ++a)
#pragma unroll
        for (int i = 0; i < 8; ++i) {
            const float ang = pos[a] * inv[i];
            float rev = ang * 0.15915494309189535f;
            rev = rev - floorf(rev);
            const float sn = __builtin_amdgcn_sinf(rev), cs = __builtin_amdgcn_cosf(rev);
            const float x1 = v[a * 16 + i], x2 = v[a * 16 + 8 + i];
            v[a * 16 + i] = x1 * cs - x2 * sn;
            v[a * 16 + 8 + i] = x2 * cs + x1 * sn;
        }
}

template <int W>
__device__ __forceinline__ void pool_task(const bf16_t* base, int t, bf16_t* outp) {
    u32x4 r[W];
#pragma unroll
    for (int k = 0; k < W; ++k) { int tt = t - W / 2 + k; tt = tt < 0 ? 0 : (tt > SEQ - 1 ? SEQ - 1 : tt); r[k] = *(const u32x4*)(base + (size_t)tt * H0LD); }
    float sum[8] = {0.f, 0.f, 0.f, 0.f, 0.f, 0.f, 0.f, 0.f};
    int cnt = 0;
#pragma unroll
    for (int k = 0; k < W; ++k) {
        const int tt = t - W / 2 + k;
        const bool ok = tt >= 0 && tt < SEQ;
        const float f = ok ? 1.f : 0.f; cnt += ok ? 1 : 0;
#pragma unroll
        for (int j = 0; j < 4; ++j) { sum[2 * j] += f * bf_lo(r[k][j]); sum[2 * j + 1] += f * bf_hi(r[k][j]); }
    }
    const float rc = 1.0f / (float)cnt;
    u32x4 o;
#pragma unroll
    for (int j = 0; j < 4; ++j) o[j] = cvt_pk_bf16(sum[2 * j] * rc - bf_lo(r[W / 2][j]), sum[2 * j + 1] * rc - bf_hi(r[W / 2][j]));
    *(u32x4*)outp = o;
}
__device__ __forceinline__ void norm_rope_store(const u32x4 (&c)[12], const float* gains, bool do_rope, int t, float outscale, bf16_t* dst) {
    float ss = 0.f;
#pragma unroll
    for (int cc = 0; cc < 12; ++cc)
#pragma unroll
        for (int j = 0; j < 4; ++j) { const float lo = bf_lo(c[cc][j]), hi = bf_hi(c[cc][j]); ss += lo * lo + hi * hi; }
    const float rstd = rsqrtf(ss * (1.0f / 96.0f) + 1e-6f);
    const float rs = rstd * outscale;
#pragma unroll
    for (int cc = 0; cc < 8; ++cc) {
        u32x4 o;
#pragma unroll
        for (int j = 0; j < 4; ++j) o[j] = cvt_pk_bf16(bf_lo(c[cc][j]) * rs * gains[cc * 8 + 2 * j], bf_hi(c[cc][j]) * rs * gains[cc * 8 + 2 * j + 1]);
        *(u32x4*)(dst + cc * 8) = o;
    }
    float v[32];
#pragma unroll
    for (int cc = 0; cc < 4; ++cc)
#pragma unroll
        for (int j = 0; j < 4; ++j) { v[cc * 8 + 2 * j] = bf_lo(c[8 + cc][j]) * rstd * gains[64 + cc * 8 + 2 * j]; v[cc * 8 + 2 * j + 1] = bf_hi(c[8 + cc][j]) * rstd * gains[64 + cc * 8 + 2 * j + 1]; }
    if (do_rope) rope32(v, t);
#pragma unroll
    for (int cc = 0; cc < 4; ++cc) {
        u32x4 o;
#pragma unroll
        for (int j = 0; j < 4; ++j) o[j] = cvt_pk_bf16(v[cc * 8 + 2 * j] * outscale, v[cc * 8 + 2 * j + 1] * outscale);
        *(u32x4*)(dst + 64 + cc * 8) = o;
    }
}

__device__ __forceinline__ void qkv_post_phase(const Params& p, unsigned char* lds) {
    const int tidx_ = opaque_tid();
    const int tid = tidx_;
    const size_t gth = (size_t)vbid() * 256 + tid, nth = (size_t)nvb() * 256;
    {
        bf16_t* Q = (bf16_t*)(p.ws + WS_R + R_Q);
        const float qs = 0.10206207261596575f * 1.4426950408889634f;
        for (size_t i = gth; i < (size_t)NTOK * NHEAD; i += nth) {
            const int tok = (int)(i >> 3);
            bf16_t* q = Q + i * QKD;
            u32x4 c[12];
#pragma unroll
            for (int cc = 0; cc < 12; ++cc) c[cc] = *(const u32x4*)(q + cc * 8);
            norm_rope_store(c, p.q_norm, true, tok & (SEQ - 1), qs, q);
        }
    }
    {
        const bf16_t* kv = (const bf16_t*)(p.ws + WS_A0);
        const bf16_t* h0 = (const bf16_t*)(p.ws + WS_R + R_H0);
        bf16_t* K = (bf16_t*)(p.ws + WS_R + R_K);
        for (size_t i = gth; i < (size_t)MROWS * NHEAD; i += nth) {
            const int row = (int)(i >> 3), hd = (int)(i & 7);
            int b, s, t; bool lat;
            if (row < NTOK) { b = row >> 14; t = row & (SEQ - 1); s = CTXL + t; lat = true; }
            else { const int rc = row - NTOK; b = rc >> 8; s = rc & 255; t = 0; lat = false; }
            u32x4 c[12];
            const bf16_t* kn = kv + (size_t)row * 1024 + hd * 128;
#pragma unroll
            for (int cc = 0; cc < 8; ++cc) c[cc] = *(const u32x4*)(kn + cc * 8);
            const bf16_t* kr = h0 + (size_t)row * H0LD + 640;
#pragma unroll
            for (int cc = 0; cc < 4; ++cc) c[8 + cc] = *(const u32x4*)(kr + cc * 8);
            norm_rope_store(c, p.k_norm, lat, t, 1.0f, K + ((size_t)(b * NHEAD + hd) * SKEYS + s) * QKD);
        }
    }
    {
        const bf16_t* kv = (const bf16_t*)(p.ws + WS_A0);
        bf16_t* Vt = (bf16_t*)(p.ws + WS_R + R_VT);
        bf16_t* tl = (bf16_t*)lds;
        const int ntile = 2 * NHEAD * (SKEYS / 64);
        for (int it = vbid(); it < ntile; it += nvb()) {
            const int st = it % (SKEYS / 64), bh = it / (SKEYS / 64), b = bh >> 3, hd = bh & 7;
            const int s0 = st * 64;
            const int row0 = (s0 < CTXL) ? (NTOK + b * CTXL + s0) : (b * SEQ + s0 - CTXL);
            {
                const int key = tid >> 2, c16 = (tid & 3) * 16;
                const bf16_t* src = kv + (size_t)(row0 + key) * 1024 + hd * 128 + 64 + c16;
                const u32x4 u0 = *(const u32x4*)src, u1 = *(const u32x4*)(src + 8);
#pragma unroll
                for (int j = 0; j < 4; ++j) {
                    tl[(c16 + 2 * j) * 72 + key] = (bf16_t)(u0[j] & 0xffffu); tl[(c16 + 2 * j + 1) * 72 + key] = (bf16_t)(u0[j] >> 16);
                    tl[(c16 + 8 + 2 * j) * 72 + key] = (bf16_t)(u1[j] & 0xffffu); tl[(c16 + 8 + 2 * j + 1) * 72 + key] = (bf16_t)(u1[j] >> 16);
                }
            }
            __syncthreads();
            {
                const int dv = tid >> 2, c16 = (tid & 3) * 16;
                const u32x4 u0 = *(const u32x4*)(tl + dv * 72 + c16), u1 = *(const u32x4*)(tl + dv * 72 + c16 + 8);
                bf16_t* o = Vt + ((size_t)(bh * VD + dv)) * SKEYS + s0 + c16;
                *(u32x4*)o = u0; *(u32x4*)(o + 8) = u1;
            }
            __syncthreads();
        }
    }
    {
        const bf16_t* h0 = (const bf16_t*)(p.ws + WS_R + R_H0);
        bf16_t* pooled = (bf16_t*)(p.ws + WS_R + R_HQN);
        const int lane = tid & 63, w = tid >> 6;
        for (int wt = vbid() * 4 + w; wt < (NTOK / 4) * 4; wt += nvb() * 4) {
            const int grp = wt & 3, tok = (wt >> 2) * 4 + (lane >> 4), ch = grp * 16 + (lane & 15);
            const int b = tok >> 14, t = tok & (SEQ - 1);
            const bf16_t* base = h0 + (size_t)(b * SEQ) * H0LD + 672 + ch * 8;
            bf16_t* outp = pooled + (size_t)tok * 512 + ch * 8;
            if (grp == 0) pool_task<2>(base, t, outp);
            else if (grp == 1) pool_task<4>(base, t, outp);
            else if (grp == 2) pool_task<8>(base, t, outp);
            else pool_task<16>(base, t, outp);
        }
    }
}

#define AT_KROW 192
#define AT_VROW 256
#define AT_KBUF (128 * AT_KROW)
#define AT_VBUF (64 * AT_VROW)
__device__ __forceinline__ void attention_item(const Params& p, int bh, int qblk, unsigned char* lds) {
    int tidx_ = threadIdx.x; asm volatile("" : "+v"(tidx_));
    const int tid = tidx_, lane = tid & 63, w = tid >> 6;
    const int r = lane & 31, hh = lane >> 5;
    const int b = bh >> 3, hd = bh & 7;
    const bf16_t* Q = (const bf16_t*)(p.ws + WS_R + R_Q);
    const bf16_t* Kg = (const bf16_t*)(p.ws + WS_R + R_K) + (size_t)bh * SKEYS * QKD;
    const bf16_t* Vg = (const bf16_t*)(p.ws + WS_R + R_VT) + (size_t)bh * VD * SKEYS;
    bf16_t* outc = (bf16_t*)(p.ws + WS_R + R_H0);

    const int tok0 = b * SEQ + qblk * 512 + w * 64 + r;
    bf16x8 qf0[6], qf1[6];
#pragma unroll
    for (int ds = 0; ds < 6; ++ds) {
        qf0[ds] = *(const bf16x8*)(Q + ((size_t)tok0 * NHEAD + hd) * QKD + ds * 16 + hh * 8);
        qf1[ds] = *(const bf16x8*)(Q + ((size_t)(tok0 + 32) * NHEAD + hd) * QKD + ds * 16 + hh * 8);
    }
    f32x16 O00, O01, O10, O11;
#pragma unroll
    for (int i = 0; i < 16; ++i) { O00[i] = 0.f; O01[i] = 0.f; O10[i] = 0.f; O11[i] = 0.f; }
    float lsum0 = 0.f, lsum1 = 0.f;

    const int wu = __builtin_amdgcn_readfirstlane(w);
    const bf16_t* pk_[3]; const bf16_t* pv_[2];
#pragma unroll
    for (int i = 0; i < 3; ++i) { const int c = tid + 512 * i, row = c / 12, sl = c % 12; pk_[i] = Kg + row * QKD + (((sl & ~3) | ((sl & 3) ^ ((row >> 2) & 3))) * 8); }
#pragma unroll
    for (int i = 0; i < 2; ++i) { const int c = tid + 512 * i, dv = c >> 4, sl = c & 15; pv_[i] = Vg + (size_t)dv * SKEYS + ((sl ^ (dv & 15)) * 8); }
#define AT_ISSUE(KT, BUF) do { \
        _Pragma("unroll") for (int i = 0; i < 3; ++i) { __builtin_amdgcn_global_load_lds((const __attribute__((address_space(1))) void*)pk_[i], \
                (LAS void*)(lds + (BUF) * (AT_KBUF + AT_VBUF) + (wu * 64 + 512 * i) * 16), 16, 0, 0); pk_[i] += 128 * QKD; } \
        _Pragma("unroll") for (int i = 0; i < 2; ++i) { __builtin_amdgcn_global_load_lds((const __attribute__((address_space(1))) void*)pv_[i], \
                (LAS void*)(lds + (BUF) * (AT_KBUF + AT_VBUF) + AT_KBUF + (wu * 64 + 512 * i) * 16), 16, 0, 0); pv_[i] += 128; } } while (0)
    const int krow = (r & 0x13) | ((r & 4) << 1) | ((r & 8) >> 1);
    const int NT = SKEYS / 128;
    const int kswz = (krow >> 2) & 3, vswz = r & 15;
    __syncthreads();
    AT_ISSUE(0, 0);
    for (int kt = 0; kt < NT; ++kt) {
        const int cur = kt & 1;
        const unsigned char* sKc = lds + cur * (AT_KBUF + AT_VBUF); const unsigned char* sVc = sKc + AT_KBUF;
        asm volatile("s_waitcnt vmcnt(0)" ::: "memory");
        __syncthreads();
        if (kt + 1 < NT) AT_ISSUE(kt + 1, cur ^ 1);
#pragma unroll 1
        for (int sub = 0; sub < 4; ++sub) {
            f32x16 S0, S1;
#pragma unroll
            for (int i = 0; i < 16; ++i) { S0[i] = 0.f; S1[i] = 0.f; }
            const unsigned char* kb = sKc + (sub * 32 + krow) * AT_KROW;
#pragma unroll
            for (int ds = 0; ds < 6; ++ds) {
                const int kc = ds * 2 + hh;
                const bf16x8 kf = *(const bf16x8*)(kb + (((kc & ~3) | ((kc & 3) ^ kswz)) << 4));
                S0 = __builtin_amdgcn_mfma_f32_32x32x16_bf16(kf, qf0[ds], S0, 0, 0, 0);
                S1 = __builtin_amdgcn_mfma_f32_32x32x16_bf16(kf, qf1[ds], S1, 0, 0, 0);
            }
            float ps0 = 0.f, ps1 = 0.f;
#pragma unroll
            for (int i = 0; i < 16; ++i) { S0[i] = __builtin_amdgcn_exp2f(S0[i]); ps0 += S0[i]; S1[i] = __builtin_amdgcn_exp2f(S1[i]); ps1 += S1[i]; }
            lsum0 += ps0; lsum1 += ps1;
            bf16x8 pb0[2], pb1[2];
#pragma unroll
            for (int s = 0; s < 2; ++s) {
                u32x4 u0, u1;
#pragma unroll
                for (int j = 0; j < 4; ++j) { u0[j] = cvt_pk_bf16(S0[8 * s + 2 * j], S0[8 * s + 2 * j + 1]); u1[j] = cvt_pk_bf16(S1[8 * s + 2 * j], S1[8 * s + 2 * j + 1]); }
                pb0[s] = __builtin_bit_cast(bf16x8, u0); pb1[s] = __builtin_bit_cast(bf16x8, u1);
            }
            const unsigned char* vb = sVc + r * AT_VROW;
#pragma unroll
            for (int s = 0; s < 2; ++s) {
                const int vc = (sub * 4 + s * 2 + hh) ^ vswz;
                const bf16x8 v0 = *(const bf16x8*)(vb + (vc << 4));
                const bf16x8 v1 = *(const bf16x8*)(vb + 32 * AT_VROW + (vc << 4));
                O00 = __builtin_amdgcn_mfma_f32_32x32x16_bf16(v0, pb0[s], O00, 0, 0, 0);
                O01 = __builtin_amdgcn_mfma_f32_32x32x16_bf16(v1, pb0[s], O01, 0, 0, 0);
                O10 = __builtin_amdgcn_mfma_f32_32x32x16_bf16(v0, pb1[s], O10, 0, 0, 0);
                O11 = __builtin_amdgcn_mfma_f32_32x32x16_bf16(v1, pb1[s], O11, 0, 0, 0);
            }
        }
    }
#undef AT_ISSUE
    lsum0 += __shfl_xor(lsum0, 32); lsum1 += __shfl_xor(lsum1, 32);
    const float rl0 = 1.0f / lsum0, rl1 = 1.0f / lsum1;
    bf16_t* o0 = outc + (size_t)tok0 * 1024 + hd * 64;
    bf16_t* o1 = o0 + (size_t)32 * 1024;
#pragma unroll
    for (int g4 = 0; g4 < 4; ++g4) {
        *(u32x2*)(o0 + 8 * g4 + 4 * hh) = (u32x2){cvt_pk_bf16(O00[4 * g4] * rl0, O00[4 * g4 + 1] * rl0), cvt_pk_bf16(O00[4 * g4 + 2] * rl0, O00[4 * g4 + 3] * rl0)};
        *(u32x2*)(o0 + 32 + 8 * g4 + 4 * hh) = (u32x2){cvt_pk_bf16(O01[4 * g4] * rl0, O01[4 * g4 + 1] * rl0), cvt_pk_bf16(O01[4 * g4 + 2] * rl0, O01[4 * g4 + 3] * rl0)};
        *(u32x2*)(o1 + 8 * g4 + 4 * hh) = (u32x2){cvt_pk_bf16(O10[4 * g4] * rl1, O10[4 * g4 + 1] * rl1), cvt_pk_bf16(O10[4 * g4 + 2] * rl1, O10[4 * g4 + 3] * rl1)};
        *(u32x2*)(o1 + 32 + 8 * g4 + 4 * hh) = (u32x2){cvt_pk_bf16(O11[4 * g4] * rl1, O11[4 * g4 + 1] * rl1), cvt_pk_bf16(O11[4 * g4 + 2] * rl1, O11[4 * g4 + 3] * rl1)};
    }
}

__device__ __forceinline__ void attention_phase(const Params& p, unsigned char* lds) {
    for (int it = (int)blockIdx.x; it < 512; it += (int)gridDim.x) {
        const int xcd = it & 7, j = it >> 3;
        attention_item(p, xcd * 2 + (j >> 5), j & 31, lds);
    }
}


#ifdef PROBE_ATTN_CHECK
__device__ __forceinline__ void attn_selfcheck(const Params& p, unsigned* flag) {
    const int tidx_ = opaque_tid();
    const int lane = tidx_ & 63, w = tidx_ >> 6;
    const bf16_t* Q = (const bf16_t*)(p.ws + WS_R + R_Q);
    const bf16_t* K = (const bf16_t*)(p.ws + WS_R + R_K);
    const bf16_t* Vt = (const bf16_t*)(p.ws + WS_R + R_VT);
    const bf16_t* outc = (const bf16_t*)(p.ws + WS_R + R_H0);
    const int gw_ = vbid() * 4 + w;
    if (gw_ >= 512) return;
    const int b = gw_ & 1, hd = (gw_ >> 1) & 7, t = ((gw_ >> 4) * 523 + (gw_ & 15) * 37 + 5) & (SEQ - 1);
    const int tok = b * SEQ + t;
    const bf16_t* q = Q + ((size_t)tok * NHEAD + hd) * QKD;
    const bf16_t* Kb = K + (size_t)(b * NHEAD + hd) * SKEYS * QKD;
    const bf16_t* Vb = Vt + (size_t)(b * NHEAD + hd) * VD * SKEYS;
    float qv[96];
#pragma unroll
    for (int d = 0; d < 96; ++d) qv[d] = bf2f(q[d]);
    float o = 0.f, l = 0.f;
    for (int s0 = 0; s0 < SKEYS; s0 += 64) {
        const bf16_t* kr = Kb + (size_t)(s0 + lane) * QKD;
        float sc = 0.f;
#pragma unroll
        for (int d = 0; d < 96; ++d) sc += qv[d] * bf2f(kr[d]);
        const float pr = exp2f(sc);
        l += pr;
        for (int kk = 0; kk < 64; ++kk) {
            const float pk = __shfl(pr, kk);
            o += pk * bf2f(Vb[(size_t)lane * SKEYS + s0 + kk]);
        }
    }
    l = wave_sum(l);
    const float ref = o / l;
    const float got = bf2f(outc[(size_t)tok * 1024 + hd * 64 + lane]);
    if (!(fabsf(got - ref) <= 0.03f * fabsf(ref) + 2e-4f)) atomicAdd(flag, 1u);
}
#endif

#ifdef PROBE_QK_CHECK
__device__ __forceinline__ void qk_selfcheck(const Params& p, unsigned* flag) {
    const int tidx_ = opaque_tid();
    const int lane = tidx_ & 63, w = tidx_ >> 6;
    const int gwv = vbid() * 4 + w;
    if (gwv >= 512) return;
    const bf16_t* h0 = (const bf16_t*)(p.ws + WS_R + R_H0);
    const bf16_t* Qb = (const bf16_t*)(p.ws + WS_R + R_Q);
    const bf16_t* Kb = (const bf16_t*)(p.ws + WS_R + R_K);
    const int hd = gwv & 7;
    const bool isk = (gwv >> 3) & 1;
    int row = ((gwv >> 4) * 1031 + 77) % NTOK;
    if (isk && (gwv >> 4) % 4 == 3) row = NTOK + ((gwv >> 4) * 13) % 512;
    const bf16_t* hr = h0 + (size_t)row * H0LD;
    float val[2] = {0.f, 0.f};
    if (!isk) {
        float ss = 0.f;
        for (int k = lane; k < 384; k += 64) { const float v = bf2f(hr[k]); ss += v * v; }
        ss = wave_sum(ss);
        const float rstd = rsqrtf(ss / 384.f + 1e-6f);
        for (int k = 0; k < 384; ++k) {
            const float a = bf2f(hr[k]) * rstd * p.q_a_norm[k];
            val[0] += a * p.q_b_w[(size_t)k * 768 + hd * 96 + lane];
            if (lane < 32) val[1] += a * p.q_b_w[(size_t)k * 768 + hd * 96 + 64 + lane];
        }
    } else {
        float ss = 0.f;
        for (int k = lane; k < 256; k += 64) { const float v = bf2f(hr[384 + k]); ss += v * v; }
        ss = wave_sum(ss);
        const float rstd = rsqrtf(ss / 256.f + 1e-6f);
        for (int k = 0; k < 256; ++k) {
            const float a = bf2f(hr[384 + k]) * rstd * p.kv_a_norm[k];
            val[0] += a * p.kv_b_w[(size_t)k * 1024 + hd * 128 + lane];
        }
        if (lane < 32) val[1] = bf2f(hr[640 + lane]);
    }
    float ss2 = val[0] * val[0] + ((lane < 32) ? val[1] * val[1] : 0.f);
    ss2 = wave_sum(ss2);
    const float r2 = rsqrtf(ss2 / 96.f + 1e-6f);
    const float* gn = isk ? p.k_norm : p.q_norm;
    val[0] = val[0] * r2 * gn[lane];
    if (lane < 32) val[1] = val[1] * r2 * gn[64 + lane];
    const bool lat = row < NTOK;
    if (lat) {
        const int t = row & (SEQ - 1);
        const int d = lane & 31, a = d >> 4, within = d & 15, half = within >> 3, i = within & 7;
        const float pos = (a == 0) ? (float)(t / 64) : (float)(t % 64);
        const float inv = powf(10000.0f, -(float)(2 * i) / 16.0f);
        float sn, cs; sincosf(pos * inv, &sn, &cs);
        const float mine = val[1];
        const float other = __shfl(val[1], (lane & 32) | (a * 16 + (half ? i : 8 + i)));
        const float rot = half == 0 ? mine * cs - other * sn : mine * cs + other * sn;
        if (lane < 32) val[1] = rot;
    }
    const float qs = isk ? 1.0f : 0.10206207261596575f * 1.4426950408889634f;
    const bf16_t* got;
    if (!isk) got = Qb + ((size_t)row * NHEAD + hd) * QKD;
    else { int b, sidx; if (lat) { b = row >> 14; sidx = CTXL + (row & (SEQ - 1)); } else { const int rc = row - NTOK; b = rc >> 8; sidx = rc & 255; } got = Kb + ((size_t)(b * NHEAD + hd) * SKEYS + sidx) * QKD; }
    const float r0 = val[0] * qs, g0 = bf2f(got[lane]);
    bool bad = !(fabsf(g0 - r0) <= 0.04f * fabsf(r0) + 0.02f * qs);
    if (lane < 32) { const float r1 = val[1] * qs, g1 = bf2f(got[64 + lane]); bad = bad || !(fabsf(g1 - r1) <= 0.04f * fabsf(r1) + 0.02f * qs); }
    if (bad) atomicAdd(flag, 1u);
}
#endif
__device__ __forceinline__ void conv_phase(const Params& p) {
    const int tidx_ = opaque_tid();
    const bf16_t* h1 = (const bf16_t*)(p.ws + WS_R + R_H1);
    bf16_t* z = (bf16_t*)(p.ws + WS_R + R_Z);
    const size_t gth = (size_t)vbid() * 256 + tidx_, nth = (size_t)nvb() * 256;
    for (size_t i = gth; i < (size_t)(NTOK / 4) * 128; i += nth) {
        const int tok0 = (int)(i >> 7) * 4, ch = (int)(i & 127) * 8;
        const int t0 = tok0 & (SEQ - 1);
        const bf16_t* hb = h1 + (size_t)(tok0 - t0) * 3072 + ch;
        u32x4 cg[6], hv[6], bg[4];
#pragma unroll
        for (int k = 0; k < 6; ++k) { int tt = t0 - 1 + k; tt = tt < 0 ? 0 : (tt > SEQ - 1 ? SEQ - 1 : tt); cg[k] = *(const u32x4*)(hb + (size_t)tt * 3072 + 1024); hv[k] = *(const u32x4*)(hb + (size_t)tt * 3072 + 2048); }
#pragma unroll
        for (int m = 0; m < 4; ++m) bg[m] = *(const u32x4*)(hb + (size_t)(t0 + m) * 3072);
        const f32x4 wa0 = *(const f32x4*)(p.c_conv + ch), wa1 = *(const f32x4*)(p.c_conv + ch + 4);
        const f32x4 wb0 = *(const f32x4*)(p.c_conv + 1024 + ch), wb1 = *(const f32x4*)(p.c_conv + 1024 + ch + 4);
        const f32x4 wc0 = *(const f32x4*)(p.c_conv + 2048 + ch), wc1 = *(const f32x4*)(p.c_conv + 2048 + ch + 4);
        float u[6][8];
#pragma unroll
        for (int k = 0; k < 6; ++k) {
            const int tt = t0 - 1 + k;
            const float f = (tt >= 0 && tt < SEQ) ? 1.f : 0.f;
#pragma unroll
            for (int j = 0; j < 4; ++j) { u[k][2 * j] = f * bf_lo(cg[k][j]) * bf_lo(hv[k][j]); u[k][2 * j + 1] = f * bf_hi(cg[k][j]) * bf_hi(hv[k][j]); }
        }
#pragma unroll
        for (int m = 0; m < 4; ++m) {
            u32x4 o;
#pragma unroll
            for (int j = 0; j < 4; ++j) {
                const float w0a = (j < 2) ? wa0[2 * j] : wa1[2 * j - 4], w0b = (j < 2) ? wa0[2 * j + 1] : wa1[2 * j - 3];
                const float w1a = (j < 2) ? wb0[2 * j] : wb1[2 * j - 4], w1b = (j < 2) ? wb0[2 * j + 1] : wb1[2 * j - 3];
                const float w2a = (j < 2) ? wc0[2 * j] : wc1[2 * j - 4], w2b = (j < 2) ? wc0[2 * j + 1] : wc1[2 * j - 3];
                const float ca = u[m][2 * j] * w0a + u[m + 1][2 * j] * w1a + u[m + 2][2 * j] * w2a;
                const float cb = u[m][2 * j + 1] * w0b + u[m + 1][2 * j + 1] * w1b + u[m + 2][2 * j + 1] * w2b;
                o[j] = cvt_pk_bf16(bf_lo(bg[m][j]) * ca, bf_hi(bg[m][j]) * cb);
            }
            *(u32x4*)(z + (size_t)(tok0 + m) * 1024 + ch) = o;
        }
    }
}

#define TK_LD 260
#define CE_D(a, b) do { const float t_ = fmaxf(a, b); b = fminf(a, b); a = t_; } while (0)
__device__ __forceinline__ void sort16_desc(float (&v)[16]) {
#pragma unroll
    for (int k = 2; k <= 16; k <<= 1)
#pragma unroll
        for (int j = k >> 1; j >= 1; j >>= 1)
#pragma unroll
            for (int i = 0; i < 16; ++i) {
                const int l = i ^ j;
                if (l > i) { if ((i & k) == 0 || k == 16) CE_D(v[i], v[l]); else CE_D(v[l], v[i]); }
            }
}
__device__ __forceinline__ void merge_top16(float (&a)[16], const float (&b)[16]) {
#pragma unroll
    for (int i = 0; i < 16; ++i) a[i] = fmaxf(a[i], b[15 - i]);
#pragma unroll
    for (int j = 8; j >= 1; j >>= 1)
#pragma unroll
        for (int i = 0; i < 16; ++i) { const int l = i ^ j; if (l > i) CE_D(a[i], a[l]); }
}
__device__ __forceinline__ float tk_val(float x) { return __uint_as_float(__float_as_uint(x) & ~127u); }
__device__ __forceinline__ void peer_topk_phase(const Params& p, int layer, const bf16_t* qp, int* eid, float* gw, unsigned char* lds) {
    const int tidx_ = opaque_tid();
    const int tid = tidx_, lane = tid & 63, w = tid >> 6;
    const int lr = lane & 15, lg = lane >> 4;
    float* sc = (float*)lds;
    float* lstA = (float*)lds;
    float* lst = (float*)(lds + 16384);
    const bf16_t* keys = (const bf16_t*)(p.ws + WS_KEYS) + (size_t)layer * 8 * 2 * 128 * 64;
    for (int it = vbid(); it < 512 * 8; it += nvb()) {
        const int hd = it & 7, tt = it >> 3, tok0 = tt * 64;
        {
            const int side = w >> 1, half = w & 1;
            f32x4 acc[4][4];
#pragma unroll
            for (int i = 0; i < 4; ++i)
#pragma unroll
                for (int j = 0; j < 4; ++j) acc[i][j] = (f32x4){0.f, 0.f, 0.f, 0.f};
            const bf16_t* qa = qp + (size_t)(tok0 + lr) * 1024 + hd * 128 + side * 64 + lg * 8;
            const bf16_t* kb = keys + ((size_t)(hd * 2 + side) * 128 + half * 64 + lr) * 64 + lg * 8;
#pragma unroll
            for (int ks = 0; ks < 2; ++ks) {
                bf16x8 af[4], bfr[4];
#pragma unroll
                for (int i = 0; i < 4; ++i) { af[i] = *(const bf16x8*)(qa + (size_t)i * 16 * 1024 + ks * 32); bfr[i] = *(const bf16x8*)(kb + i * 16 * 64 + ks * 32); }
#pragma unroll
                for (int i = 0; i < 4; ++i)
#pragma unroll
                    for (int j = 0; j < 4; ++j) acc[i][j] = __builtin_amdgcn_mfma_f32_16x16x32_bf16(af[i], bfr[j], acc[i][j], 0, 0, 0);
            }
#pragma unroll
            for (int i = 0; i < 4; ++i)
#pragma unroll
                for (int j = 0; j < 4; ++j)
#pragma unroll
                    for (int jj = 0; jj < 4; ++jj) sc[(i * 16 + lg * 4 + jj) * TK_LD + side * 128 + half * 64 + j * 16 + lr] = acc[i][j][jj];
        }
        __syncthreads();
        float m0[16];
        {
            const int token = tid & 63, side = (tid >> 6) & 1, half = tid >> 7;
            const float* s = sc + token * TK_LD + side * 128 + half * 64;
            float g1[16], g2[16], g3[16];
#pragma unroll
            for (int k4 = 0; k4 < 4; ++k4) {
                const f32x4 a = *(const f32x4*)(s + k4 * 4), b = *(const f32x4*)(s + 16 + k4 * 4), c = *(const f32x4*)(s + 32 + k4 * 4), d = *(const f32x4*)(s + 48 + k4 * 4);
#pragma unroll
                for (int e = 0; e < 4; ++e) {
                    const unsigned ix = (unsigned)(half * 64 + k4 * 4 + e);
                    m0[k4 * 4 + e] = __uint_as_float((__float_as_uint(a[e]) & ~127u) | ix);
                    g1[k4 * 4 + e] = __uint_as_float((__float_as_uint(b[e]) & ~127u) | (ix + 16u));
                    g2[k4 * 4 + e] = __uint_as_float((__float_as_uint(c[e]) & ~127u) | (ix + 32u));
                    g3[k4 * 4 + e] = __uint_as_float((__float_as_uint(d[e]) & ~127u) | (ix + 48u));
                }
            }
            sort16_desc(m0); sort16_desc(g1); sort16_desc(g2); sort16_desc(g3);
            merge_top16(m0, g1); merge_top16(g2, g3); merge_top16(m0, g2);
        }
        __syncthreads();
        {
            const int token = tid & 63, side = (tid >> 6) & 1, half = tid >> 7;
            float* o = lstA + ((token * 2 + side) * 2 + half) * 16;
#pragma unroll
            for (int q = 0; q < 4; ++q) *(f32x4*)(o + q * 4) = (f32x4){m0[q * 4], m0[q * 4 + 1], m0[q * 4 + 2], m0[q * 4 + 3]};
        }
        __syncthreads();
        if (tid < 128) {
            const int token = tid & 63, side = tid >> 6;
            const float* a = lstA + ((token * 2 + side) * 2) * 16;
            float x[16], y[16];
#pragma unroll
            for (int q = 0; q < 4; ++q) {
                const f32x4 u = *(const f32x4*)(a + q * 4), v = *(const f32x4*)(a + 16 + q * 4);
#pragma unroll
                for (int e = 0; e < 4; ++e) { x[q * 4 + e] = u[e]; y[q * 4 + e] = v[e]; }
            }
            merge_top16(x, y);
            float* o = lst + (token * 2 + side) * 16;
#pragma unroll
            for (int q = 0; q < 4; ++q) *(f32x4*)(o + q * 4) = (f32x4){x[q * 4], x[q * 4 + 1], x[q * 4 + 2], x[q * 4 + 3]};
        }
        __syncthreads();
        if (tid < 64) {
            const int token = tid;
            float v1[16], v2[16];
#pragma unroll
            for (int q = 0; q < 4; ++q) {
                const f32x4 u = *(const f32x4*)(lst + (token * 2) * 16 + q * 4), v = *(const f32x4*)(lst + (token * 2 + 1) * 16 + q * 4);
#pragma unroll
                for (int e = 0; e < 4; ++e) { v1[q * 4 + e] = tk_val(u[e]); v2[q * 4 + e] = tk_val(v[e]); }
            }
#define TK_CAND(I, J) __uint_as_float((__float_as_uint(v1[I] + v2[J]) & ~255u) | (unsigned)(255 - (16 * (I) + (J))))
            float T[16], R[16];
#pragma unroll
            for (int j = 0; j < 16; ++j) T[j] = TK_CAND(0, j);
#pragma unroll
            for (int j = 0; j < 16; ++j) R[j] = (j < 8) ? TK_CAND(1, j & 7) : -3.0e38f;
            merge_top16(T, R);
            R[0] = TK_CAND(2, 0); R[1] = TK_CAND(2, 1); R[2] = TK_CAND(2, 2); R[3] = TK_CAND(2, 3); R[4] = TK_CAND(2, 4);
            R[5] = TK_CAND(3, 0); R[6] = TK_CAND(3, 1); R[7] = TK_CAND(3, 2); R[8] = TK_CAND(3, 3);
            R[9] = TK_CAND(4, 0); R[10] = TK_CAND(4, 1); R[11] = TK_CAND(4, 2);
            R[12] = -3.0e38f; R[13] = -3.0e38f; R[14] = -3.0e38f; R[15] = -3.0e38f;
            sort16_desc(R); merge_top16(T, R);
            R[0] = TK_CAND(5, 0); R[1] = TK_CAND(5, 1); R[2] = TK_CAND(6, 0); R[3] = TK_CAND(6, 1); R[4] = TK_CAND(7, 0); R[5] = TK_CAND(7, 1);
            R[6] = TK_CAND(8, 0); R[7] = TK_CAND(9, 0); R[8] = TK_CAND(10, 0); R[9] = TK_CAND(11, 0); R[10] = TK_CAND(12, 0); R[11] = TK_CAND(13, 0);
            R[12] = TK_CAND(14, 0); R[13] = TK_CAND(15, 0); R[14] = -3.0e38f; R[15] = -3.0e38f;
            sort16_desc(R); merge_top16(T, R);
#undef TK_CAND
            const float m = T[0];
            float e[16], sum = 0.f;
#pragma unroll
            for (int j = 0; j < 16; ++j) { e[j] = __expf(T[j] - m); sum += e[j]; }
            const float rs = 1.0f / sum;
            int* eo = eid + (size_t)(tok0 + token) * 128 + hd * 2;
            float* go = gw + (size_t)(tok0 + token) * 128 + hd * 2;
#pragma unroll
            for (int j = 0; j < 16; ++j) {
                const unsigned pl = 255u - (__float_as_uint(T[j]) & 255u);
                const unsigned i1 = __float_as_uint(lst[(token * 2) * 16 + (pl >> 4)]) & 127u;
                const unsigned i2 = __float_as_uint(lst[(token * 2 + 1) * 16 + (pl & 15u)]) & 127u;
                eo[(j & 7) * 16 + (j >> 3)] = (int)(i1 * 128u + i2);
                go[(j & 7) * 16 + (j >> 3)] = e[j] * rs;
            }
        }
        __syncthreads();
    }
}

__device__ __forceinline__ int dpp_xor1(int v) { return __builtin_amdgcn_update_dpp(0, v, 0xB1, 0xf, 0xf, true); }
__device__ __forceinline__ int dpp_xor2(int v) { return __builtin_amdgcn_update_dpp(0, v, 0x4E, 0xf, 0xf, true); }
__device__ __forceinline__ int dpp_hmir(int v) { return __builtin_amdgcn_update_dpp(0, v, 0x141, 0xf, 0xf, true); }
__device__ __forceinline__ void peer_u_phase(const Params& p, const SliceMap sm, int layer, const int* eid, float* pa) {
    const int tidx_ = opaque_tid();
    const int lane = tidx_ & 63, w = __builtin_amdgcn_readfirstlane(tidx_ >> 6), sub = lane >> 3, ch = lane & 7;
    const int j = sm.j & 3, rank = sm.rank4, nb = sm.nb4;
    const unsigned char* U4 = p.ws + WS_UTAB + ((size_t)(layer * 4 + j) * NEXP) * 128 + ch * 16;
    const unsigned char* X8 = p.ws + WS_XQ8 + (size_t)j * NTOK * 256 + ch * 32;
    const float* SX = (const float*)(p.ws + WS_SX) + (size_t)j * NTOK;
    const int* eidl = eid + sub * 16;
    float* paj = pa + (size_t)j * NTOK * 128 + sub * 16 + ch;
    const int stride = nb * 4;
    const int tfirst = rank * 4 + w;
    if (tfirst >= NTOK) return;
    const int niter = (NTOK - 1 - tfirst) / stride + 1, tlast = tfirst + (niter - 1) * stride;
    u32x4 EA[4], EB[4], XAl, XAh, XBl, XBh, BA[16], BB[16];
    float sA, sB;
#define U_S1E(T, E_) do { _Pragma("unroll") for (int q = 0; q < 4; ++q) E_[q] = *(const u32x4*)(eidl + (size_t)(T) * 128 + q * 4); } while (0)
#define U_S1X(T, Xl_, Xh_, S_) do { Xl_ = *(const u32x4*)(X8 + (size_t)(T) * 256); Xh_ = *(const u32x4*)(X8 + (size_t)(T) * 256 + 16); S_ = SX[(T)]; } while (0)
#define U_S2(E_, B_) do { _Pragma("unroll") for (int it = 0; it < 16; ++it) B_[it] = *(const u32x4*)(U4 + (size_t)E_[it >> 2][it & 3] * 128); } while (0)
#define U_S3(T, VALID, Xl_, Xh_, S_, B_, EN_) do { \
        int r0_ = 0, r1_ = 0; \
        _Pragma("unroll") for (int it = 0; it < 16; ++it) { \
            int al_ = 0, ah_ = 0; \
            _Pragma("unroll") for (int q = 0; q < 4; ++q) { al_ = __builtin_amdgcn_sdot8((int)B_[it][q], (int)Xl_[q], al_, false); ah_ = __builtin_amdgcn_sdot8((int)B_[it][q], (int)Xh_[q], ah_, false); } \
            int a_ = al_ + (ah_ << 4); \
            B_[it] = *(const u32x4*)(U4 + (size_t)EN_[it >> 2][it & 3] * 128); \
            a_ += dpp_xor1(a_); a_ += dpp_xor2(a_); a_ += dpp_hmir(a_); \
            if (it < 8) r0_ = (ch == it) ? a_ : r0_; else r1_ = (ch == it - 8) ? a_ : r1_; } \
        if (VALID) { paj[(size_t)(T) * 128] = (float)r0_ * S_; paj[(size_t)(T) * 128 + 8] = (float)r1_ * S_; } \
    } while (0)
#define U_CL(T) ((T) < tlast ? (T) : tlast)
    int t0 = tfirst;
    U_S1E(t0, EA); U_S1X(t0, XAl, XAh, sA);
    { const int t1 = U_CL(t0 + stride); U_S1E(t1, EB); U_S1X(t1, XBl, XBh, sB); }
    U_S2(EA, BA);
    U_S2(EB, BB);
    { const int t2 = U_CL(t0 + 2 * stride), t3 = U_CL(t0 + 3 * stride); U_S1E(t2, EA); U_S1E(t3, EB); }
    for (int it2 = 0; it2 < niter; it2 += 2) {
        const int t1 = U_CL(t0 + stride), t2 = U_CL(t0 + 2 * stride), t3 = U_CL(t0 + 3 * stride), t4 = U_CL(t0 + 4 * stride), t5 = U_CL(t0 + 5 * stride);
        U_S3(t0, true, XAl, XAh, sA, BA, EA);
        U_S1X(t2, XAl, XAh, sA);
        U_S1E(t4, EA);
        U_S3(t1, (it2 + 1 < niter), XBl, XBh, sB, BB, EB);
        U_S1X(t3, XBl, XBh, sB);
        U_S1E(t5, EB);
        t0 += 2 * stride;
    }
#undef U_S1E
#undef U_S1X
#undef U_S2
#undef U_S3
#undef U_CL
}
__device__ __forceinline__ void peer_c_phase(const Params& p, int layer, const float* pa, const int* eid, float* gw) {
    const int tidx_ = opaque_tid();
    const size_t nth = (size_t)nvb() * 256;
    const float* su = (const float*)(p.ws + WS_SU) + (size_t)layer * NEXP;
    const float* sv = (const float*)(p.ws + WS_SV) + (size_t)layer * NEXP;
    for (size_t i = (size_t)vbid() * 256 + tidx_; i < (size_t)NTOK * 128; i += nth) {
        float s = 0.f;
#pragma unroll
        for (int j = 0; j < 4; ++j) s += pa[(size_t)j * NTOK * 128 + i];
        const int e = eid[i];
        const float a = s * su[e];
        const float cf = gw[i] * 0.5f * a * (1.0f + erff(a * 0.70710678118654752f)) * sv[e];
        ((unsigned*)gw)[i] = (cvt_pk_bf16(0.f, cf) & 0xffff0000u) | (unsigned)e;
    }
}
__device__ __forceinline__ void swap32_add(float& a, float& b) {
    const auto r = __builtin_amdgcn_permlane32_swap(__float_as_uint(a), __float_as_uint(b), false, false);
    const unsigned r0 = r[0], r1 = r[1];
    a = __uint_as_float(r0) + __uint_as_float(r1);
}
__device__ __forceinline__ void swap16_add(float& a, float& b) {
    const auto r = __builtin_amdgcn_permlane16_swap(__float_as_uint(a), __float_as_uint(b), false, false);
    const unsigned r0 = r[0], r1 = r[1];
    a = __uint_as_float(r0) + __uint_as_float(r1);
}
template <bool LAST>
__device__ __forceinline__ void peer_v_phase(const Params& p, const SliceMap sm, int layer, const unsigned* cep, bf16_t* xs, float* xout) {
    const int tidx_ = opaque_tid();
    const int lane = tidx_ & 63, w = __builtin_amdgcn_readfirstlane(tidx_ >> 6), sub = lane >> 3, ch = lane & 7, rw = lane >> 4;
    const int j = sm.j & 3, rank = sm.rank4, nb = sm.nb4;
    const unsigned char* V4 = p.ws + WS_VTAB + ((size_t)(layer * 4 + j) * NEXP) * 128 + ch * 16;
    const float* modv = (const float*)(p.ws + WS_MODV) + (size_t)layer * 3 * 6144 + 5 * 1024 + j * 256 + ch * 32 + rw * 8;
    const __amdgpu_buffer_rsrc_t xrs = __builtin_amdgcn_make_buffer_rsrc(xs, 0, NTOK * DM * 2, 0x00020000);
    const __amdgpu_buffer_rsrc_t ors = __builtin_amdgcn_make_buffer_rsrc(xout, 0, NTOK * DM * 4, 0x00020000);
    const unsigned x_lane = ((lane & 8) == 0) ? (unsigned)((j * 256 + ch * 32 + rw * 8) * 2) : 0xffffffffu;
    const unsigned o_lane = ((lane & 8) == 0) ? (unsigned)((j * 256 + ch * 32 + rw * 8) * 4) : 0xffffffffu;
    const unsigned* cepl = cep + sub * 16;
    const int stride = nb * 4;
    const int tfirst = rank * 4 + w;
    if (tfirst >= NTOK) return;
    const int niter = (NTOK - 1 - tfirst) / stride + 1, tlast = tfirst + (niter - 1) * stride;
    u32x4 C0[4], C1[4], C2[4], HA[8], HB[8];
#define V_IDS(T, C_) do { _Pragma("unroll") for (int q = 0; q < 4; ++q) C_[q] = *(const u32x4*)(cepl + (size_t)(T) * 128 + q * 4); } while (0)
#define V_LOADH(HH, C_, H8) do { _Pragma("unroll") for (int it = 0; it < 8; ++it) HH[it] = *(const u32x4*)(V4 + (size_t)(C_[(H8) * 2 + (it >> 2)][it & 3] & 0xffffu) * 128); } while (0)
#define V_COMP(HH, C_, H8) do { _Pragma("unroll") for (int it = 0; it < 8; ++it) { \
            const float c_ = __uint_as_float(C_[(H8) * 2 + (it >> 2)][it & 3] & 0xffff0000u); \
            const f32x2 c2_ = {c_, c_}; \
            _Pragma("unroll") for (int q = 0; q < 4; ++q) { \
                const unsigned w_ = HH[it][q]; \
                acc2[4 * q]     = __builtin_elementwise_fma(__builtin_amdgcn_cvt_scalef32_pk_f32_fp4(w_, 1.0f, 0), c2_, acc2[4 * q]); \
                acc2[4 * q + 1] = __builtin_elementwise_fma(__builtin_amdgcn_cvt_scalef32_pk_f32_fp4(w_, 1.0f, 1), c2_, acc2[4 * q + 1]); \
                acc2[4 * q + 2] = __builtin_elementwise_fma(__builtin_amdgcn_cvt_scalef32_pk_f32_fp4(w_, 1.0f, 2), c2_, acc2[4 * q + 2]); \
                acc2[4 * q + 3] = __builtin_elementwise_fma(__builtin_amdgcn_cvt_scalef32_pk_f32_fp4(w_, 1.0f, 3), c2_, acc2[4 * q + 3]); } } } while (0)
#define V_CL(T) ((T) < tlast ? (T) : tlast)
    int t = tfirst;
    V_IDS(t, C0);
    { const int t1 = V_CL(t + stride); V_IDS(t1, C1); }
    V_LOADH(HA, C0, 0);
    for (int it2 = 0; it2 < niter; ++it2) {
        const int t2 = V_CL(t + 2 * stride);
        V_LOADH(HB, C0, 1);
        V_IDS(t2, C2);
        const u32x4 xr_ = __builtin_bit_cast(u32x4, __builtin_amdgcn_raw_buffer_load_b128(xrs, x_lane, t * (DM * 2), 0));
        f32x2 acc2[16];
#pragma unroll
        for (int k = 0; k < 16; ++k) acc2[k] = (f32x2){0.f, 0.f};
        V_COMP(HA, C0, 0);
        V_LOADH(HA, C1, 0);
        V_COMP(HB, C0, 1);
        float acc[32];
#pragma unroll
        for (int k = 0; k < 16; ++k) { acc[2 * k] = acc2[k][0]; acc[2 * k + 1] = acc2[k][1]; }
#pragma unroll
        for (int k = 0; k < 16; ++k) swap32_add(acc[k], acc[k + 16]);
#pragma unroll
        for (int k = 0; k < 8; ++k) swap16_add(acc[k], acc[k + 8]);
        const f32x4 gt0 = *(const f32x4*)(modv + (t >> 14) * 6144), gt1 = *(const f32x4*)(modv + (t >> 14) * 6144 + 4);
        f32x4 xv0 = (f32x4){bf_lo(xr_[0]), bf_hi(xr_[0]), bf_lo(xr_[1]), bf_hi(xr_[1])}, xv1 = (f32x4){bf_lo(xr_[2]), bf_hi(xr_[2]), bf_lo(xr_[3]), bf_hi(xr_[3])};
#pragma unroll
        for (int k = 0; k < 4; ++k) {
            const float tot0 = acc[k] + __int_as_float(__builtin_amdgcn_update_dpp(0, __float_as_int(acc[k]), 0x128, 0xf, 0xf, true));
            const float tot1 = acc[k + 4] + __int_as_float(__builtin_amdgcn_update_dpp(0, __float_as_int(acc[k + 4]), 0x128, 0xf, 0xf, true));
            xv0[k] += gt0[k] * tot0; xv1[k] += gt1[k] * tot1;
        }
        if (LAST) {
            __builtin_amdgcn_raw_buffer_store_b128(__builtin_bit_cast(u32x4, xv0), ors, o_lane, t * (DM * 4), 0);
            __builtin_amdgcn_raw_buffer_store_b128(__builtin_bit_cast(u32x4, xv1), ors, (o_lane == 0xffffffffu) ? o_lane : o_lane + 16u, t * (DM * 4), 0);
        } else {
            __builtin_amdgcn_raw_buffer_store_b128(__builtin_bit_cast(u32x4, (u32x4){cvt_pk_bf16(xv0[0], xv0[1]), cvt_pk_bf16(xv0[2], xv0[3]), cvt_pk_bf16(xv1[0], xv1[1]), cvt_pk_bf16(xv1[2], xv1[3])}), xrs, x_lane, t * (DM * 2), 0);
        }
#pragma unroll
        for (int q = 0; q < 4; ++q) { C0[q] = C1[q]; C1[q] = C2[q]; }
        t += stride;
    }
#undef V_IDS
#undef V_LOADH
#undef V_COMP
#undef V_CL
}

#ifndef PROBE_MASK
#define PROBE_MASK 0u
#endif
#if USE_CG
#define GRID_BARRIER() cg::this_grid().sync()
#else
#define GRID_BARRIER() xcd_barrier(xb)
#endif
#define PHASE_END(n) do { GRID_BARRIER(); if (PROBE_MASK) { const unsigned long long now_ = __builtin_amdgcn_s_memrealtime(); if ((PROBE_MASK >> (n)) & 1u) probe_dt += now_ - t_prev; t_prev = now_; } } while (0)

__global__ void __launch_bounds__(512, 2) fwd_megakernel(Params p) {
    __shared__ __attribute__((aligned(16))) unsigned char lds_all[LDS_BYTES];
    if (threadIdx.x == 0) { *(u32x4*)(lds_all + LDS_XB_OFF) = (u32x4){0u, 0u, 0u, 0u}; }
    __syncthreads();
    XcdBarrier xb = xcd_barrier_post((unsigned*)(p.ws + WS_BAR), (volatile LAS unsigned*)(lds_all + LDS_XB_OFF));
    unsigned char* lds = lds_all + __builtin_amdgcn_readfirstlane((int)(threadIdx.x >> 8)) * LDS_HALF;
    unsigned char* ws = p.ws;
    const float* modv = (const float*)(ws + WS_MODV);
    bf16_t* A0 = (bf16_t*)(ws + WS_A0);
    bf16_t* XS = (bf16_t*)(ws + WS_XS);
    unsigned long long t_prev = PROBE_MASK ? __builtin_amdgcn_s_memrealtime() : 0ull, probe_dt = 0ull;

    phase0(p, lds);
    PHASE_END(0);
    const SliceMap sm = peer_slice_map(xb);
    SliceMap8 s8; s8.j = sm.j; s8.rank = sm.rank >> 1; s8.nb = sm.nb >> 1;
    rowmod_phase<false>(p, p.x, p.ctx, p.norm_mix, 0, 0, A0, MROWS, nullptr);
    PHASE_END(1);
    {
        GemmArgs g{}; g.A = A0; g.lda = 1024; g.Bt = (const bf16_t*)(ws + WS_WIN_T); g.ldb = 1024; g.K = 1024;
        g.C = (bf16_t*)(ws + WS_R + R_H0); g.ldc = H0LD; g.colscale = nullptr;
        gemm8_phase<EPI_BF16, false>(g, s8, MROWS / 256, H0LD / 256, lds_all);
    }
    PHASE_END(2);
    {
        GemmArgs g{}; g.A = (const bf16_t*)(ws + WS_R + R_H0); g.lda = H0LD; g.Bt = (const bf16_t*)(ws + WS_QB_T); g.ldb = 384; g.K = 384;
        g.C = (bf16_t*)(ws + WS_R + R_Q); g.ldc = 768; g.colscale = nullptr;
        GemmArgs g2{}; g2.A = (const bf16_t*)(ws + WS_R + R_H0) + 384; g2.lda = H0LD; g2.Bt = (const bf16_t*)(ws + WS_KVB_T); g2.ldb = 256; g2.K = 256;
        g2.C = A0; g2.ldc = 1024; g2.colscale = nullptr;
        gemm_phase<EPI_BF16, true>(g, sm, NTOK / 128, 6, lds);
        gemm_phase<EPI_BF16, true>(g2, sm, MROWS / 128, 8, lds);
    }
    PHASE_END(4);
    qkv_post_phase(p, lds);
    PHASE_END(5);
#ifdef PROBE_QK_CHECK
    qk_selfcheck(p, (unsigned*)(ws + WS_BAR) + 4001);
    GRID_BARRIER();
#endif
    {
        for (int t = vbid(); t < 4 * (NTOK / 128); t += nvb()) {
            const int grp = t & 3, tm = t >> 2;
            GemmArgs g{}; g.A = (const bf16_t*)(ws + WS_R + R_HQN) + grp * 128; g.lda = 512; g.Bt = (const bf16_t*)(ws + WS_POOL_T) + grp * 128 * 128; g.ldb = 128; g.K = 128;
            g.C = (bf16_t*)(ws + WS_R + R_H0) + 512 + grp * 128; g.ldc = 1024; g.colscale = p.pool_scale + grp * 128;
            gemm_tile<EPI_BF16>(g, tm, 0, lds);
        }
    }
    PHASE_END(6);
    attention_phase(p, lds_all);
    PHASE_END(7);
#ifdef PROBE_ATTN_CHECK
    attn_selfcheck(p, (unsigned*)(ws + WS_BAR) + 4000);
    GRID_BARRIER();
#endif
    {
        GemmArgs g{}; g.A = (const bf16_t*)(ws + WS_R + R_H0); g.lda = 1024; g.Bt = (const bf16_t*)(ws + WS_WOUT_T); g.ldb = 1024; g.K = 1024;
        g.xin = p.x; g.xs = XS; g.gate = modv + 2 * 1024; g.gate_bstride = 6144;
        gemm8_phase<EPI_RESID, false>(g, s8, NTOK / 256, 4, lds_all);
    }
    PHASE_END(8);
    rowmod_phase<true>(p, XS, p.ctx, p.norm_ffn, 0, 3, A0, NTOK, ws + WS_XQ8);
    PHASE_END(9);
    {
        GemmArgs g{}; g.A = A0; g.lda = 1024; g.Bt = (const bf16_t*)(ws + WS_WQ_T); g.ldb = 1024; g.K = 1024;
        g.C = (bf16_t*)(ws + WS_R + R_Q); g.ldc = 1024; g.colscale = nullptr;
        gemm8_phase<EPI_BF16, false>(g, s8, NTOK / 256, 4, lds_all);
    }
    PHASE_END(10);
    peer_topk_phase(p, 0, (const bf16_t*)(ws + WS_R + R_Q), (int*)(ws + WS_R + R_VT), (float*)(ws + WS_R + R_VT + 16777216ull), lds);
    PHASE_END(11);
    peer_u_phase(p, sm, 0, (const int*)(ws + WS_R + R_VT), (float*)(ws + WS_R + R_H0));
    PHASE_END(12);
    peer_c_phase(p, 0, (const float*)(ws + WS_R + R_H0), (const int*)(ws + WS_R + R_VT), (float*)(ws + WS_R + R_VT + 16777216ull));
    PHASE_END(20);
    peer_v_phase<false>(p, sm, 0, (const unsigned*)(ws + WS_R + R_VT + 16777216ull), XS, p.out);
    PHASE_END(21);
    rowmod_phase<true>(p, XS, p.ctx, p.norm_mix + 1024, 1, 0, A0, NTOK, nullptr);
    PHASE_END(13);
    {
        GemmArgs g{}; g.A = A0; g.lda = 1024; g.Bt = (const bf16_t*)(ws + WS_CIN_T); g.ldb = 1024; g.K = 1024;
        g.C = (bf16_t*)(ws + WS_R + R_H1); g.ldc = 3072; g.colscale = nullptr;
        gemm8_phase<EPI_BF16, false>(g, s8, NTOK / 256, 12, lds_all);
    }
    PHASE_END(14);
    conv_phase(p);
    PHASE_END(15);
    {
        GemmArgs g{}; g.A = (const bf16_t*)(ws + WS_R + R_Z); g.lda = 1024; g.Bt = (const bf16_t*)(ws + WS_COUT_T); g.ldb = 1024; g.K = 1024;
        g.xin = nullptr; g.xs = XS; g.gate = modv + 3 * 6144 + 2 * 1024; g.gate_bstride = 6144;
        gemm8_phase<EPI_RESIDB, false>(g, s8, NTOK / 256, 4, lds_all);
    }
    PHASE_END(16);
    rowmod_phase<true>(p, XS, p.ctx, p.norm_ffn + 1024, 1, 3, A0, NTOK, ws + WS_XQ8);
    PHASE_END(17);
    {
        GemmArgs g{}; g.A = A0; g.lda = 1024; g.Bt = (const bf16_t*)(ws + WS_WQ_T) + 1024 * 1024; g.ldb = 1024; g.K = 1024;
        g.C = (bf16_t*)(ws + WS_R + R_H1); g.ldc = 1024; g.colscale = nullptr;
        gemm8_phase<EPI_BF16, false>(g, s8, NTOK / 256, 4, lds_all);
    }
    PHASE_END(18);
    peer_topk_phase(p, 1, (const bf16_t*)(ws + WS_R + R_H1), (int*)(ws + WS_R + 67108864ull), (float*)(ws + WS_R + 67108864ull + 16777216ull), lds);
    PHASE_END(19);
    peer_u_phase(p, sm, 1, (const int*)(ws + WS_R + 67108864ull), (float*)(ws + WS_R + 100663296ull));
    PHASE_END(22);
    peer_c_phase(p, 1, (const float*)(ws + WS_R + 100663296ull), (const int*)(ws + WS_R + 67108864ull), (float*)(ws + WS_R + 67108864ull + 16777216ull));
    PHASE_END(23);
    peer_v_phase<true>(p, sm, 1, (const unsigned*)(ws + WS_R + 67108864ull + 16777216ull), XS, p.out);
#if defined(PROBE_ATTN_CHECK) || defined(PROBE_QK_CHECK)
    GRID_BARRIER();
    if ((xb_ld((unsigned*)(ws + WS_BAR) + 4000) | xb_ld((unsigned*)(ws + WS_BAR) + 4001)) != 0u && blockIdx.x == 0) { for (int i = threadIdx.x; i < 65536; i += 512) p.out[i] = __uint_as_float(0x7fc00000u); }
#endif
    if (PROBE_MASK) {
        PHASE_END(24);
        if (blockIdx.x == 0 && threadIdx.x == 0) { const unsigned long long t0 = __builtin_amdgcn_s_memrealtime(); while (__builtin_amdgcn_s_memrealtime() - t0 < probe_dt) __builtin_amdgcn_s_sleep(8); }
    }
}

extern "C" void kernel_launch(void* const* d_in, const int* in_sizes, int n_in, void* d_out, int out_size, void* d_ws, size_t ws_size, hipStream_t stream) {
    static int grid = 0;
    if (grid == 0) {
        if (n_in != 25 || out_size != NTOK * DM || ws_size < WS_TOTAL) {
            fprintf(stderr, "kernel_launch: unexpected sizes (n_in %d, out %d, ws %zu, need %llu)\n", n_in, out_size, ws_size, (unsigned long long)WS_TOTAL);
            grid = -1; return;
        }
        int dev = 0, cus = 0, per_cu = 0;
        (void)hipGetDevice(&dev);
        (void)hipDeviceGetAttribute(&cus, hipDeviceAttributeMultiprocessorCount, dev);
        if (hipOccupancyMaxActiveBlocksPerMultiprocessor(&per_cu, (const void*)fwd_megakernel, 512, 0) != hipSuccess || per_cu < 1) { fprintf(stderr, "kernel_launch: occupancy query failed\n"); grid = -1; return; }
        if (per_cu > 1) per_cu = 1;
        grid = cus * per_cu;
    }
    if (grid < 0) return;
    Params p{};
    const float** f = (const float**)&p.x;
    for (int i = 0; i < 25; ++i) f[i] = (const float*)d_in[i];
    p.out = (float*)d_out; p.ws = (unsigned char*)d_ws;
    (void)hipMemsetAsync(d_ws, 0, 16384, stream);
#if USE_CG
    void* args[] = {&p};
    hipError_t e = hipLaunchCooperativeKernel((const void*)fwd_megakernel, dim3(grid), dim3(512), args, 0, stream);
    if (e != hipSuccess) fprintf(stderr, "cooperative launch failed: %s (grid %d)\n", hipGetErrorString(e), grid);
#else
    hipLaunchKernelGGL(fwd_megakernel, dim3(grid), dim3(512), 0, stream, p);
#endif
}
```

```cpp
#include <hip/hip_runtime.h>
#include <stdint.h>
#include <stdio.h>
#include <hip/hip_cooperative_groups.h>
namespace cg = cooperative_groups;
#ifndef USE_CG
#define USE_CG 0
#endif

#define NTOK   32768
#define SEQ    16384
#define DM     1024
#define CTXL   256
#define MROWS  33280
#define SKEYS  16640
#define NHEAD  8
#define QKD    96
#define VD     64
#define H0LD   1280
#define NEXP   16384

typedef unsigned short bf16_t;
typedef short bf16x8 __attribute__((ext_vector_type(8)));
typedef float f32x4 __attribute__((ext_vector_type(4)));
typedef float f32x16 __attribute__((ext_vector_type(16)));
typedef unsigned u32x4 __attribute__((ext_vector_type(4)));
typedef unsigned u32x2 __attribute__((ext_vector_type(2)));
typedef long i64x2 __attribute__((ext_vector_type(2)));
typedef int i32x8 __attribute__((ext_vector_type(8)));

#define WS_BAR      0ull
#define WS_MODV     16384ull
#define WS_WIN_T    (WS_MODV + 147456ull)
#define WS_QB_T     (WS_WIN_T + 2621440ull)
#define WS_KVB_T    (WS_QB_T + 589824ull)
#define WS_POOL_T   (WS_KVB_T + 524288ull)
#define WS_WOUT_T   (WS_POOL_T + 131072ull)
#define WS_CIN_T    (WS_WOUT_T + 2097152ull)
#define WS_COUT_T   (WS_CIN_T + 6291456ull)
#define WS_WQ_T     (WS_COUT_T + 2097152ull)
#define WS_KEYS     (WS_WQ_T + 4194304ull)
#define WS_UTAB     (WS_KEYS + 524288ull)
#define WS_VTAB     (WS_UTAB + 33554432ull)
#define WS_XQ8      (WS_VTAB + 33554432ull)
#define WS_SU       (WS_XQ8 + 33554432ull)
#define WS_SX       (WS_SU + 131072ull)
#define WS_SV       (WS_SX + 524288ull)
#define WS_A0       (WS_SX + 1048576ull)
#define WS_R        (WS_A0 + 68157440ull)
#define R_H0        0ull
#define R_HQN       (R_H0 + 85196800ull)
#define R_CKVN      (R_HQN + 25559040ull)
#define R_Q         (R_CKVN + 17039360ull)
#define R_K         (R_Q + 50331648ull)
#define R_VT        (R_K + 51118080ull)
#define R_END0      (R_VT + 34078720ull)
#define R_H1        0ull
#define R_Z         201326592ull
#define R_END1      (R_Z + 67108864ull)
#define WS_XS       (WS_R + (R_END1 > R_END0 ? R_END1 : R_END0))
#define WS_TOTAL    (WS_XS + 67108864ull)


struct Params {
    const float *x, *c, *ctx, *c_ctx, *mod_w, *mod_b, *norm_mix, *norm_ffn, *ab_w_in, *q_a_norm, *q_b_w, *kv_a_norm, *kv_b_w,
                *q_norm, *k_norm, *pool_w, *pool_scale, *ab_w_out, *c_w_in, *c_conv, *c_w_out, *peer_wq, *peer_keys, *peer_u, *peer_v;
    float* out;
    unsigned char* ws;
};

typedef float f32x2 __attribute__((ext_vector_type(2)));
typedef _Float16 h16x2 __attribute__((ext_vector_type(2)));
typedef __bf16 bf16x2_t __attribute__((ext_vector_type(2)));
__device__ __forceinline__ unsigned cvt_pk_bf16(float lo, float hi) {
    const f32x2 v = {lo, hi}; const bf16x2_t b = __builtin_convertvector(v, bf16x2_t); return __builtin_bit_cast(unsigned, b);
}
__device__ __forceinline__ float bf_lo(unsigned u) { return __uint_as_float(u << 16); }
__device__ __forceinline__ float bf_hi(unsigned u) { return __uint_as_float(u & 0xffff0000u); }
__device__ __forceinline__ float bf2f(bf16_t b) { return __uint_as_float(((unsigned)b) << 16); }
#define LDS_HALF 75776
__device__ __forceinline__ int opaque_tid() { int t = threadIdx.x & 255; asm volatile("" : "+v"(t)); return t; }
__device__ __forceinline__ int vbid() { return (int)blockIdx.x * 2 + __builtin_amdgcn_readfirstlane((int)(threadIdx.x >> 8)); }
__device__ __forceinline__ int nvb() { return (int)gridDim.x * 2; }
__device__ __forceinline__ float wave_sum(float v) {
#pragma unroll
    for (int o = 32; o >= 1; o >>= 1) v += __shfl_xor(v, o);
    return v;
}

#define DPPF(v, CTRL) __int_as_float(__builtin_amdgcn_update_dpp(0, __float_as_int(v), (CTRL), 0xf, 0xf, true))
__device__ __forceinline__ float wave_sum_u(float v) {
    v += DPPF(v, 0xB1); v += DPPF(v, 0x4E); v += DPPF(v, 0x141); v += DPPF(v, 0x140);
    const int i = __float_as_int(v);
    return (__int_as_float(__builtin_amdgcn_readlane(i, 0)) + __int_as_float(__builtin_amdgcn_readlane(i, 16))) + (__int_as_float(__builtin_amdgcn_readlane(i, 32)) + __int_as_float(__builtin_amdgcn_readlane(i, 48)));
}
__device__ __forceinline__ float wave_max_u(float v) {
    v = fmaxf(v, DPPF(v, 0xB1)); v = fmaxf(v, DPPF(v, 0x4E)); v = fmaxf(v, DPPF(v, 0x141)); v = fmaxf(v, DPPF(v, 0x140));
    const int i = __float_as_int(v);
    return fmaxf(fmaxf(__int_as_float(__builtin_amdgcn_readlane(i, 0)), __int_as_float(__builtin_amdgcn_readlane(i, 16))), fmaxf(__int_as_float(__builtin_amdgcn_readlane(i, 32)), __int_as_float(__builtin_amdgcn_readlane(i, 48))));
}

#define XB_TMO      128
#define XB_XCNT(j)  (256  + 64 * (j))
#define XB_XSUB(j)  (1280 + 64 * (j))
#define XB_XGEN(j)  (2304 + 64 * (j))
#define XB_TOP      3328
#define XB_TOPGEN   3392
#define XCD_BAR_WORDS 3456
#define XB_SPIN_CAP (1u << 25)
#define LAS __attribute__((address_space(3)))

__device__ __forceinline__ unsigned xb_ld(unsigned* p)              { return __hip_atomic_load(p, __ATOMIC_RELAXED, __HIP_MEMORY_SCOPE_AGENT); }
__device__ __forceinline__ unsigned xb_add(unsigned* p, unsigned v) { return __hip_atomic_fetch_add(p, v, __ATOMIC_RELAXED, __HIP_MEMORY_SCOPE_AGENT); }
__device__ __forceinline__ unsigned xb_xcc_id() { return (unsigned)__builtin_amdgcn_s_getreg((3 << 11) | 20) & 0xFu; }
#define XB_SPIN(cond, bar) do { unsigned _sp = 0; while (cond) { __builtin_amdgcn_s_sleep(1); \
    if ((++_sp & 255u) == 0u) { if (xb_ld(&(bar)[XB_TMO])) break; if (_sp > XB_SPIN_CAP) { atomicAdd(&(bar)[XB_TMO], 1u); break; } } } } while (0)

struct XcdBarrier { unsigned* bar; unsigned x; volatile LAS unsigned* st; };

__device__ __forceinline__ XcdBarrier xcd_barrier_post(unsigned* bar, volatile LAS unsigned* st) {
    XcdBarrier b; b.bar = bar; b.x = xb_xcc_id(); b.st = st;
    if (threadIdx.x == 0) st[2] = xb_add(&bar[XB_XCNT(b.x)], 1u);
    return b;
}
__device__ __forceinline__ void xcd_barrier_complete(unsigned* bar, unsigned x, unsigned& nloc, unsigned& nx) {
    const unsigned G = gridDim.x * gridDim.y * gridDim.z;
    unsigned sum, cnt, mine, sp = 0u;
    for (;;) {
        sum = 0u; cnt = 0u; mine = 0u;
#pragma unroll
        for (unsigned j = 0; j < 16; ++j) { const unsigned c = xb_ld(&bar[XB_XCNT(j)]); sum += c; cnt += (c > 0u) ? 1u : 0u; mine = (j == x) ? c : mine; }
        if (sum == G) break;
        __builtin_amdgcn_s_sleep(1);
        if ((++sp & 255u) == 0u) { if (xb_ld(&bar[XB_TMO])) break; if (sp > XB_SPIN_CAP) { atomicAdd(&bar[XB_TMO], 1u); break; } }
    }
    nloc = mine > 0u ? mine : 1u; nx = cnt > 0u ? cnt : 1u;
}
__device__ __forceinline__ void xcd_barrier(const XcdBarrier& b) {
    asm volatile("s_waitcnt vmcnt(0)" ::: "memory");
    __syncthreads();
    if (threadIdx.x == 0) {
        unsigned* bar = b.bar;
        __builtin_amdgcn_s_waitcnt(0);
        unsigned nloc = b.st[0], nx = b.st[1];
        if (nloc == 0u) { xcd_barrier_complete(bar, b.x, nloc, nx); b.st[0] = nloc; b.st[1] = nx; }
        const unsigned old = xb_add(&bar[XB_XSUB(b.x)], 1u);
        const unsigned gen = old / nloc;
        if (old + 1u == (gen + 1u) * nloc) {
            __builtin_amdgcn_fence(__ATOMIC_RELEASE, "agent");
            asm volatile("s_waitcnt vmcnt(0)" ::: "memory");
            const unsigned og = xb_add(&bar[XB_TOP], 1u);
            const unsigned tg = og / nx;
            if (og + 1u == (tg + 1u) * nx) xb_add(&bar[XB_TOPGEN], 1u);
            else XB_SPIN(xb_ld(&bar[XB_TOPGEN]) == tg, bar);
            __builtin_amdgcn_fence(__ATOMIC_ACQUIRE, "agent");
            xb_add(&bar[XB_XGEN(b.x)], 1u);
            asm volatile("s_waitcnt vmcnt(0)" ::: "memory");
        } else {
            XB_SPIN(xb_ld(&bar[XB_XGEN(b.x)]) == gen, bar);
            __builtin_amdgcn_fence(__ATOMIC_ACQUIRE, "agent");
            asm volatile("s_waitcnt vmcnt(0)" ::: "memory");
        }
    }
    __syncthreads();
}

#define LDS_BYTES (2 * 75776 + 16)
#define LDS_XB_OFF (2 * 75776)

__device__ __forceinline__ void p0_modvec(const Params& p, float* lds_f, int task) {
    const int tidx_ = opaque_tid();
    const int l = task / 384, cc = task % 384;
    const int tid = tidx_, lane = tid & 63, w = tid >> 6, col = lane & 15, rsub = lane >> 4;
    for (int i = tid; i < 3072; i += 256) {
        const int v = i >> 10, k = i & 1023;
        const float c = (v < 2) ? p.c[v * 1024 + k] : p.c_ctx[k];
        lds_f[i] = c / (1.f + __expf(-c));
    }
    __syncthreads();
    const float* W = p.mod_w + (size_t)l * 1024 * 6144 + cc * 16 + col;
    float a0 = 0.f, a1 = 0.f, a2 = 0.f;
    const int k0 = w * 256 + rsub;
#pragma unroll 16
    for (int m = 0; m < 64; ++m) {
        const int k = k0 + 4 * m;
        const float wv = W[(size_t)k * 6144];
        a0 += wv * lds_f[k]; a1 += wv * lds_f[1024 + k]; a2 += wv * lds_f[2048 + k];
    }
    a0 += __shfl_xor(a0, 16); a0 += __shfl_xor(a0, 32);
    a1 += __shfl_xor(a1, 16); a1 += __shfl_xor(a1, 32);
    a2 += __shfl_xor(a2, 16); a2 += __shfl_xor(a2, 32);
    float* red = lds_f + 3072;
    if (lane < 16) { red[(w * 3 + 0) * 16 + col] = a0; red[(w * 3 + 1) * 16 + col] = a1; red[(w * 3 + 2) * 16 + col] = a2; }
    __syncthreads();
    if (tid < 48) {
        const int v = tid >> 4, ln = tid & 15;
        const float sm_ = red[(0 * 3 + v) * 16 + ln] + red[(1 * 3 + v) * 16 + ln] + red[(2 * 3 + v) * 16 + ln] + red[(3 * 3 + v) * 16 + ln];
        const int cl = cc * 16 + ln;
        float* modv = (float*)(p.ws + WS_MODV);
        modv[(l * 3 + v) * 6144 + cl] = sm_ + p.mod_b[l * 6144 + cl];
    }
    __syncthreads();
}

struct TrD { const float* src; bf16_t* dst; int K, N; const float* kgain; };
__device__ __forceinline__ void p0_transpose_tile(const TrD d, int tile, float* lds_f) {
    const int tidx_ = opaque_tid();
    const int tilesK = d.K >> 6;
    const int tn = tile / tilesK, tk = tile % tilesK;
    const int n0 = tn * 64, k0 = tk * 64;
    const int tid = tidx_;
#pragma unroll
    for (int i = 0; i < 4; ++i) {
        const int r = (tid >> 4) + 16 * i, c4 = (tid & 15) * 4;
        f32x4 v = {0.f, 0.f, 0.f, 0.f};
        if (n0 + c4 < d.N) v = *(const f32x4*)(d.src + (size_t)(k0 + r) * d.N + n0 + c4);
        if (d.kgain) v = v * d.kgain[k0 + r];
        float* q = lds_f + r * 65 + c4;
        q[0] = v[0]; q[1] = v[1]; q[2] = v[2]; q[3] = v[3];
    }
    __syncthreads();
    {
        const int n = tid >> 2, kc = (tid & 3) * 16;
        unsigned w[8];
#pragma unroll
        for (int j = 0; j < 8; ++j) w[j] = cvt_pk_bf16(lds_f[(kc + 2 * j) * 65 + n], lds_f[(kc + 2 * j + 1) * 65 + n]);
        bf16_t* o = d.dst + (size_t)(n0 + n) * d.K + k0 + kc;
        *(u32x4*)o = (u32x4){w[0], w[1], w[2], w[3]};
        *(u32x4*)(o + 8) = (u32x4){w[4], w[5], w[6], w[7]};
    }
    __syncthreads();
}

__device__ __forceinline__ void cvt_flat(const float* src, bf16_t* dst, size_t n) {
    const int tidx_ = opaque_tid();
    const size_t nth = (size_t)nvb() * 256;
    for (size_t i = ((size_t)vbid() * 256 + tidx_) * 8; i < n; i += nth * 8) {
        const f32x4 a = *(const f32x4*)(src + i), b = *(const f32x4*)(src + i + 4);
        *(u32x4*)(dst + i) = (u32x4){cvt_pk_bf16(a[0], a[1]), cvt_pk_bf16(a[2], a[3]), cvt_pk_bf16(b[0], b[1]), cvt_pk_bf16(b[2], b[3])};
    }
}

__device__ __forceinline__ unsigned q4(float v) { int q = (int)rintf(v); q = q > 7 ? 7 : q; q = q < -8 ? -8 : q; return (unsigned)q & 0xfu; }
__device__ __forceinline__ void cvt_tab_i4(const float* src, unsigned char* dst, float* su) {
    const int tidx_ = opaque_tid();
    const int lane = tidx_ & 63, w = tidx_ >> 6;
    const int half = NEXP;
    for (int row = vbid() * 4 + w; row < half; row += nvb() * 4) {
        f32x4 v[2][4]; float am[2] = {0.f, 0.f}, sq[2] = {0.f, 0.f};
#pragma unroll
        for (int h = 0; h < 2; ++h) {
            const float* sr = src + (size_t)(row + h * half) * DM + lane * 16;
#pragma unroll
            for (int q = 0; q < 4; ++q) v[h][q] = *(const f32x4*)(sr + q * 4);
        }
#pragma unroll
        for (int h = 0; h < 2; ++h)
#pragma unroll
            for (int q = 0; q < 4; ++q) {
                am[h] = fmaxf(am[h], fmaxf(fmaxf(fabsf(v[h][q][0]), fabsf(v[h][q][1])), fmaxf(fabsf(v[h][q][2]), fabsf(v[h][q][3]))));
                sq[h] += v[h][q][0] * v[h][q][0] + v[h][q][1] * v[h][q][1] + v[h][q][2] * v[h][q][2] + v[h][q][3] * v[h][q][3];
            }
#pragma unroll
        for (int o = 32; o >= 1; o >>= 1) { am[0] = fmaxf(am[0], __shfl_xor(am[0], o)); am[1] = fmaxf(am[1], __shfl_xor(am[1], o)); sq[0] += __shfl_xor(sq[0], o); sq[1] += __shfl_xor(sq[1], o); }
#pragma unroll
        for (int h = 0; h < 2; ++h) {
            const float step = fminf(am[h] * (1.0f / 7.0f), 0.3352f * sqrtf(sq[h] * (1.0f / 1024.0f)));
            const float sc = step > 0.f ? 1.0f / step : 0.f;
            u32x2 o2;
#pragma unroll
            for (int d = 0; d < 2; ++d) {
                const f32x4 a = v[h][2 * d], b = v[h][2 * d + 1];
                o2[d] = q4(a[0] * sc) | (q4(a[1] * sc) << 4) | (q4(a[2] * sc) << 8) | (q4(a[3] * sc) << 12) | (q4(b[0] * sc) << 16) | (q4(b[1] * sc) << 20) | (q4(b[2] * sc) << 24) | (q4(b[3] * sc) << 28);
            }
            *(u32x2*)(dst + (((size_t)h * 4 + (lane >> 4)) * NEXP + row) * 128 + (lane & 15) * 8) = o2;
            if (lane == 0) su[2 * (row + h * half)] = step;
        }
    }
}

__device__ __forceinline__ void cvt_tab_fp4(const float* src, unsigned char* dst, float* sv) {
    const int tidx_ = opaque_tid();
    const int lane = tidx_ & 63, w = tidx_ >> 6;
    const int half = NEXP;
    for (int row = vbid() * 4 + w; row < half; row += nvb() * 4) {
        f32x4 v[2][4]; float am[2] = {0.f, 0.f}, sq[2] = {0.f, 0.f};
#pragma unroll
        for (int h = 0; h < 2; ++h) {
            const float* sr = src + (size_t)(row + h * half) * DM + lane * 16;
#pragma unroll
            for (int q = 0; q < 4; ++q) v[h][q] = *(const f32x4*)(sr + q * 4);
        }
#pragma unroll
        for (int h = 0; h < 2; ++h)
#pragma unroll
            for (int q = 0; q < 4; ++q) {
                am[h] = fmaxf(am[h], fmaxf(fmaxf(fabsf(v[h][q][0]), fabsf(v[h][q][1])), fmaxf(fabsf(v[h][q][2]), fabsf(v[h][q][3]))));
                sq[h] += v[h][q][0] * v[h][q][0] + v[h][q][1] * v[h][q][1] + v[h][q][2] * v[h][q][2] + v[h][q][3] * v[h][q][3];
            }
#pragma unroll
        for (int o = 32; o >= 1; o >>= 1) { am[0] = fmaxf(am[0], __shfl_xor(am[0], o)); am[1] = fmaxf(am[1], __shfl_xor(am[1], o)); sq[0] += __shfl_xor(sq[0], o); sq[1] += __shfl_xor(sq[1], o); }
#pragma unroll
        for (int h = 0; h < 2; ++h) {
            const float unit = fminf(am[h] * (1.0f / 6.0f), 0.49f * sqrtf(sq[h] * (1.0f / 1024.0f)));
            const float sc = unit > 0.f ? 1.0f / unit : 0.f;
            unsigned o0 = 0u, o1 = 0u;
            o0 = __builtin_amdgcn_cvt_scalef32_pk_fp4_f32(o0, v[h][0][0] * sc, v[h][0][1] * sc, 1.0f, 0);
            o0 = __builtin_amdgcn_cvt_scalef32_pk_fp4_f32(o0, v[h][0][2] * sc, v[h][0][3] * sc, 1.0f, 1);
            o0 = __builtin_amdgcn_cvt_scalef32_pk_fp4_f32(o0, v[h][1][0] * sc, v[h][1][1] * sc, 1.0f, 2);
            o0 = __builtin_amdgcn_cvt_scalef32_pk_fp4_f32(o0, v[h][1][2] * sc, v[h][1][3] * sc, 1.0f, 3);
            o1 = __builtin_amdgcn_cvt_scalef32_pk_fp4_f32(o1, v[h][2][0] * sc, v[h][2][1] * sc, 1.0f, 0);
            o1 = __builtin_amdgcn_cvt_scalef32_pk_fp4_f32(o1, v[h][2][2] * sc, v[h][2][3] * sc, 1.0f, 1);
            o1 = __builtin_amdgcn_cvt_scalef32_pk_fp4_f32(o1, v[h][3][0] * sc, v[h][3][1] * sc, 1.0f, 2);
            o1 = __builtin_amdgcn_cvt_scalef32_pk_fp4_f32(o1, v[h][3][2] * sc, v[h][3][3] * sc, 1.0f, 3);
            *(u32x2*)(dst + (((size_t)h * 4 + (lane >> 4)) * NEXP + row) * 128 + (lane & 15) * 8) = (u32x2){o0, o1};
            if (lane == 0) sv[2 * (row + h * half) + 1] = unit;
        }
    }
}

#define F8_ASCALE 8.0f
#define WS_F8WORD(i) ((unsigned*)(p.ws + WS_BAR) + 4010 + (i))
__device__ __forceinline__ void absmax_flat(const float* src, size_t n, unsigned* word) {
    const int tidx_ = opaque_tid();
    const size_t nth = (size_t)nvb() * 256;
    float am = 0.f;
    for (size_t i = ((size_t)vbid() * 256 + tidx_) * 4; i < n; i += nth * 4) {
        const f32x4 v = *(const f32x4*)(src + i);
        am = fmaxf(am, fmaxf(fmaxf(fabsf(v[0]), fabsf(v[1])), fmaxf(fabsf(v[2]), fabsf(v[3]))));
    }
#pragma unroll
    for (int o = 32; o >= 1; o >>= 1) am = fmaxf(am, __shfl_xor(am, o));
    if ((tidx_ & 63) == 0 && am > 0.f) atomicMax(word, __float_as_uint(am));
}
__device__ __forceinline__ float f8_weight_scale(unsigned* word) {
    const float am = __uint_as_float(xb_ld(word));
    return (am > 0.f && am < 1e30f) ? ldexpf(1.0f, (int)floorf(log2f(240.0f / am))) : 1.0f;
}
__device__ __forceinline__ unsigned pk4_fp8(float a, float b, float c, float d) {
    int w = 0;
    w = __builtin_amdgcn_cvt_pk_fp8_f32(fminf(fmaxf(a, -448.f), 448.f), fminf(fmaxf(b, -448.f), 448.f), w, false);
    w = __builtin_amdgcn_cvt_pk_fp8_f32(fminf(fmaxf(c, -448.f), 448.f), fminf(fmaxf(d, -448.f), 448.f), w, true);
    return (unsigned)w;
}
__device__ __forceinline__ void transpose_tile_f8(const float* src, unsigned char* dst8, int K, int N, float scale, int tile, float* lds_f, bool cvmap = false) {
    const int tid = opaque_tid();
    const int tilesK = K >> 6;
    const int tn = tile / tilesK, tk = tile % tilesK;
    const int n0 = tn * 64, k0 = tk * 64;
#pragma unroll
    for (int i = 0; i < 4; ++i) {
        const int r = (tid >> 4) + 16 * i, c4 = (tid & 15) * 4;
        f32x4 v = {0.f, 0.f, 0.f, 0.f};
        if (n0 + c4 < N) v = *(const f32x4*)(src + (size_t)(k0 + r) * N + n0 + c4);
        v = v * scale;
        float* q = lds_f + r * 65 + c4;
        q[0] = v[0]; q[1] = v[1]; q[2] = v[2]; q[3] = v[3];
    }
    __syncthreads();
    {
        const int n = tid >> 2, kc = (tid & 3) * 16;
        u32x4 w;
#pragma unroll
        for (int j = 0; j < 4; ++j) w[j] = pk4_fp8(lds_f[(kc + 4 * j) * 65 + n], lds_f[(kc + 4 * j + 1) * 65 + n], lds_f[(kc + 4 * j + 2) * 65 + n], lds_f[(kc + 4 * j + 3) * 65 + n]);
        int nd = n0;
        if (cvmap && n0 >= 1024) { const int isv = n0 >= 2048 ? 1 : 0, chn = n0 - 1024 - isv * 1024; nd = 1024 + (chn >> 7) * 256 + isv * 128 + (chn & 127); }
        *(u32x4*)(dst8 + (size_t)(nd + n) * K + k0 + kc) = w;
    }
    __syncthreads();
}

__device__ __forceinline__ void phase0(const Params& p, unsigned char* lds) {
    float* lds_f = (float*)lds;
    for (int t = vbid(); t < 768; t += nvb()) p0_modvec(p, lds_f, t);
    unsigned char* ws = p.ws;
#define TRANSPOSE(SRC, DSTOFF, KK, NN, NPAD) TRANSPOSE_G(SRC, DSTOFF, KK, NN, NPAD, nullptr)
#define TRANSPOSE_G(SRC, DSTOFF, KK, NN, NPAD, KG) do { const TrD d_{(SRC), (bf16_t*)(ws + (DSTOFF)), (KK), (NN), (KG)}; \
        for (int t = vbid(); t < ((NPAD) / 64) * ((KK) / 64); t += nvb()) p0_transpose_tile(d_, t, lds_f); } while (0)
    TRANSPOSE_G(p.q_b_w, WS_QB_T, 384, 768, 768, p.q_a_norm);
    TRANSPOSE_G(p.kv_b_w, WS_KVB_T, 256, 1024, 1024, p.kv_a_norm);
    for (int g = 0; g < 4; ++g) TRANSPOSE(p.pool_w + g * 128 * 128, WS_POOL_T + (unsigned long long)g * 128 * 128 * 2, 128, 128, 128);
    TRANSPOSE(p.ab_w_out, WS_WOUT_T, 1024, 1024, 1024);
    TRANSPOSE(p.c_w_out, WS_COUT_T, 1024, 1024, 1024);
    TRANSPOSE(p.peer_wq, WS_WQ_T, 1024, 1024, 1024);
    TRANSPOSE(p.peer_wq + 1024 * 1024, WS_WQ_T + 2097152ull, 1024, 1024, 1024);
#undef TRANSPOSE
#undef TRANSPOSE_G
    cvt_flat(p.peer_keys, (bf16_t*)(p.ws + WS_KEYS), 262144);
    absmax_flat(p.ab_w_in, (size_t)1024 * 1184, WS_F8WORD(0));
    absmax_flat(p.c_w_in, (size_t)1024 * 3072, WS_F8WORD(1));
    cvt_tab_i4(p.peer_u, p.ws + WS_UTAB, (float*)(p.ws + WS_SV));
    cvt_tab_fp4(p.peer_v, p.ws + WS_VTAB, (float*)(p.ws + WS_SV));
}

template <bool XBF, bool F8OUT = false>
__device__ __forceinline__ void rowmod_phase(const Params& p, const void* src_lat_, const float* src_ctx, const float* gain, int layer, int shift_idx, bf16_t* dst, int nrows, unsigned char* xq8) {
    const int tidx_ = opaque_tid();
    const int lane = tidx_ & 63, w = tidx_ >> 6;
    const float* modv = (const float*)(p.ws + WS_MODV) + (size_t)layer * 3 * 6144;
    const int stride = nvb() * 4;
    int row = vbid() * 4 + w;
    if (row >= nrows) return;
    const int rlast = row + ((nrows - 1 - row) / stride) * stride;
    f32x4 x[4], xn[4];
#define RM_LOAD(R, X) do { \
        if (XBF) { const bf16_t* src = (const bf16_t*)src_lat_ + (size_t)(R) * DM;            \
            _Pragma("unroll") for (int i = 0; i < 4; ++i) { const u32x2 u = *(const u32x2*)(src + i * 256 + lane * 4); X[i] = (f32x4){bf_lo(u[0]), bf_hi(u[0]), bf_lo(u[1]), bf_hi(u[1])}; } \
        } else { const float* src = ((R) < NTOK) ? (const float*)src_lat_ + (size_t)(R) * DM : src_ctx + (size_t)((R) - NTOK) * DM; \
            _Pragma("unroll") for (int i = 0; i < 4; ++i) X[i] = *(const f32x4*)(src + i * 256 + lane * 4); } } while (0)
    RM_LOAD(row, x);
    f32x4 ma[4], mb[4];
    int vcur = -1;
    for (;;) {
        const int nrow = row + stride, nr = nrow < rlast ? nrow : rlast;
        RM_LOAD(nr, xn);
        const int v = (row < NTOK) ? (row >> 14) : 2;
        if (v != vcur) {
            vcur = v;
            const float* sh = modv + v * 6144 + shift_idx * 1024;
            const float* sc = sh + 1024;
#pragma unroll
            for (int i = 0; i < 4; ++i) {
                const int d0 = i * 256 + lane * 4;
                const f32x4 g = *(const f32x4*)(gain + d0), s_ = *(const f32x4*)(sh + d0), c = *(const f32x4*)(sc + d0);
                ma[i] = g * (c + 1.f); mb[i] = s_;
            }
        }
        float ss = 0.f;
#pragma unroll
        for (int i = 0; i < 4; ++i) ss += x[i][0] * x[i][0] + x[i][1] * x[i][1] + x[i][2] * x[i][2] + x[i][3] * x[i][3];
        ss = wave_sum_u(ss);
        const float rstd = rsqrtf(ss * (1.0f / 1024.0f) + 1e-6f);
#pragma unroll
        for (int i = 0; i < 4; ++i) {
            const int d0 = i * 256 + lane * 4;
            float y[4];
#pragma unroll
            for (int j = 0; j < 4; ++j) y[j] = x[i][j] * rstd * ma[i][j] + mb[i][j];
            if (F8OUT) *(unsigned*)((unsigned char*)dst + (size_t)row * DM + d0) = pk4_fp8(y[0] * F8_ASCALE, y[1] * F8_ASCALE, y[2] * F8_ASCALE, y[3] * F8_ASCALE);
            else *(u32x2*)(dst + (size_t)row * DM + d0) = (u32x2){cvt_pk_bf16(y[0], y[1]), cvt_pk_bf16(y[2], y[3])};
            if (xq8) {
                const float am = wave_max_u(fmaxf(fmaxf(fabsf(y[0]), fabsf(y[1])), fmaxf(fabsf(y[2]), fabsf(y[3]))));
                const float scq = am > 0.f ? 119.0f / am : 0.f;
                unsigned nl = 0u, nh = 0u;
#pragma unroll
                for (int j = 0; j < 4; ++j) { int q = (int)rintf(y[j] * scq); q = q > 119 ? 119 : q; q = q < -119 ? -119 : q; nl |= ((unsigned)q & 15u) << (4 * j); nh |= ((unsigned)((q + 8) >> 4) & 15u) << (4 * j); }
                const bool odd_ = (lane & 1) != 0;
                const unsigned got = (unsigned)__builtin_amdgcn_update_dpp(0, (int)(odd_ ? nl : nh), 0xB1, 0xf, 0xf, true);
                const unsigned word = odd_ ? (got | (nh << 16)) : (nl | (got << 16));
                *(unsigned*)(xq8 + ((size_t)i * NTOK + row) * 256 + (lane >> 3) * 32 + (odd_ ? 16 : 0) + ((lane >> 1) & 3) * 4) = word;
                if (lane == 0) ((float*)(p.ws + WS_SX))[(size_t)i * NTOK + row] = am * (1.0f / 119.0f);
            }
        }
        if (nrow > rlast) break;
        row = nrow;
#pragma unroll
        for (int i = 0; i < 4; ++i) x[i] = xn[i];
    }
#undef RM_LOAD
}

#define EPI_BF16   0
#define EPI_RESID  1
#define EPI_RESIDB 2
struct GemmArgs {
    const bf16_t* A; int lda;
    const bf16_t* Bt; int ldb;
    int K;
    bf16_t* C; int ldc; const float* colscale;
    float oscale;
    int cv_from;
    float* ssq_out;
    const float* rowss; int ss_a, ss_b;
    const float* xin; bf16_t* xs; const float* gate; int gate_bstride;
};

__device__ __forceinline__ int swz(int row, int ch) { return row * 128 + ((ch ^ ((row >> 1) & 7)) << 4); }

template <int EPI, bool NORM = false>
__device__ __forceinline__ void gemm_tile(const GemmArgs& g, int tm, int tn, unsigned char* lds) {
    const int tidx_ = opaque_tid();
    const int tid = tidx_, lane = tid & 63, w = __builtin_amdgcn_readfirstlane(tid >> 6);
    const int wm = w >> 1, wn = w & 1;
    const int lr = lane & 15, lg = lane >> 4;
    const bf16_t* Ag = g.A + (size_t)(tm * 128) * g.lda;
    const bf16_t* Bg = g.Bt + (size_t)(tn * 128) * g.ldb;
    f32x4 acc[4][4];
#pragma unroll
    for (int i = 0; i < 4; ++i)
#pragma unroll
        for (int j = 0; j < 4; ++j) acc[i][j] = (f32x4){0.f, 0.f, 0.f, 0.f};
    float ssq[4] = {0.f, 0.f, 0.f, 0.f};
    const bf16_t* pa_[4]; const bf16_t* pb_[4];
#pragma unroll
    for (int i = 0; i < 4; ++i) {
        const int c = tid + 256 * i, row = c >> 3, ch = (c & 7) ^ ((row >> 1) & 7);
        pa_[i] = Ag + (size_t)row * g.lda + ch * 8;
        pb_[i] = Bg + (size_t)row * g.ldb + ch * 8;
    }
    const int nk = g.K >> 6;
#define GEMM_ISSUE(KT, BUF) do { _Pragma("unroll") for (int i = 0; i < 4; ++i) { \
        __builtin_amdgcn_global_load_lds((const __attribute__((address_space(1))) void*)(pa_[i] + (KT) * 64), (LAS void*)(lds + (BUF) * 32768 + (w * 64 + 256 * i) * 16), 16, 0, 0); \
        __builtin_amdgcn_global_load_lds((const __attribute__((address_space(1))) void*)(pb_[i] + (KT) * 64), (LAS void*)(lds + (BUF) * 32768 + 16384 + (w * 64 + 256 * i) * 16), 16, 0, 0); } } while (0)
    GEMM_ISSUE(0, 0);
    for (int kt = 0; kt < nk; ++kt) {
        const int cur = kt & 1;
        asm volatile("s_waitcnt vmcnt(0)" ::: "memory");
        __syncthreads();
        if (kt + 1 < nk) GEMM_ISSUE(kt + 1, cur ^ 1);
        const unsigned char* sAc = lds + cur * 32768; const unsigned char* sBc = sAc + 16384;
#pragma unroll
        for (int ks = 0; ks < 2; ++ks) {
            bf16x8 af[4], bfr[4];
#pragma unroll
            for (int i = 0; i < 4; ++i) {
                af[i]  = *(const bf16x8*)(sAc + swz(wm * 64 + i * 16 + lr, ks * 4 + lg));
                bfr[i] = *(const bf16x8*)(sBc + swz(wn * 64 + i * 16 + lr, ks * 4 + lg));
            }
            if (NORM) {
#pragma unroll
                for (int i = 0; i < 4; ++i) {
                    const u32x4 u_ = __builtin_bit_cast(u32x4, af[i]);
                    const unsigned u0 = u_[0], u1 = u_[1], u2 = u_[2], u3 = u_[3];
                    ssq[i] = __builtin_amdgcn_fdot2_f32_bf16(__builtin_bit_cast(bf16x2_t, u0), __builtin_bit_cast(bf16x2_t, u0), ssq[i], false);
                    ssq[i] = __builtin_amdgcn_fdot2_f32_bf16(__builtin_bit_cast(bf16x2_t, u1), __builtin_bit_cast(bf16x2_t, u1), ssq[i], false);
                    ssq[i] = __builtin_amdgcn_fdot2_f32_bf16(__builtin_bit_cast(bf16x2_t, u2), __builtin_bit_cast(bf16x2_t, u2), ssq[i], false);
                    ssq[i] = __builtin_amdgcn_fdot2_f32_bf16(__builtin_bit_cast(bf16x2_t, u3), __builtin_bit_cast(bf16x2_t, u3), ssq[i], false);
                }
            }
#pragma unroll
            for (int i = 0; i < 4; ++i)
#pragma unroll
                for (int j = 0; j < 4; ++j) acc[i][j] = __builtin_amdgcn_mfma_f32_16x16x32_bf16(bfr[j], af[i], acc[i][j], 0, 0, 0);
        }
    }
#undef GEMM_ISSUE
    if (NORM) {
#pragma unroll
        for (int i = 0; i < 4; ++i) {
            float t_ = ssq[i]; t_ += __shfl_xor(t_, 16); t_ += __shfl_xor(t_, 32);
            const float rs_ = rsqrtf(t_ / (float)g.K + 1e-6f);
#pragma unroll
            for (int j = 0; j < 4; ++j) acc[i][j] = acc[i][j] * rs_;
        }
    }
    __syncthreads();
#pragma unroll
    for (int i = 0; i < 4; ++i) {
        const int row = tm * 128 + wm * 64 + i * 16 + lr;
#pragma unroll
        for (int j = 0; j < 4; ++j) {
            const int col = tn * 128 + wn * 64 + j * 16 + lg * 4;
            f32x4 v = acc[i][j];
            if (EPI == EPI_BF16) {
                if (g.colscale) { const f32x4 s = *(const f32x4*)(g.colscale + col); v = v * s; }
                *(u32x2*)(g.C + (size_t)row * g.ldc + col) = (u32x2){cvt_pk_bf16(v[0], v[1]), cvt_pk_bf16(v[2], v[3])};
            } else {
                const f32x4 gt = *(const f32x4*)(g.gate + (size_t)(row >> 14) * g.gate_bstride + col);
                f32x4 xi;
                if (EPI == EPI_RESID) xi = *(const f32x4*)(g.xin + (size_t)row * DM + col);
                else { const u32x2 u = *(const u32x2*)(g.xs + (size_t)row * DM + col); xi = (f32x4){bf_lo(u[0]), bf_hi(u[0]), bf_lo(u[1]), bf_hi(u[1])}; }
                const f32x4 xo = xi + gt * v;
                *(u32x2*)(g.xs + (size_t)row * DM + col) = (u32x2){cvt_pk_bf16(xo[0], xo[1]), cvt_pk_bf16(xo[2], xo[3])};
            }
        }
    }
}

struct SliceMap { int j, rank, nb, rank4, nb4; };
__device__ __forceinline__ SliceMap peer_slice_map(const XcdBarrier& xb) {
    const int half_ = __builtin_amdgcn_readfirstlane((int)(threadIdx.x >> 8));
    SliceMap m; m.j = (int)blockIdx.x & 7; m.rank = ((int)blockIdx.x >> 3) * 2 + half_; m.nb = (((int)gridDim.x - m.j + 7) >> 3) * 2;
    int nbp = (((int)gridDim.x - (m.j ^ 4) + 7) >> 3) * 2;
#if !USE_CG
    unsigned sum = 0u; bool ok = true; unsigned mine = 0u, theirs = 0u;
#pragma unroll
    for (unsigned q = 0; q < 8; ++q) { const unsigned c = xb_ld(&xb.bar[XB_XCNT(q)]); sum += c; ok = ok && (c > 0u); mine = (q == xb.x) ? c : mine; theirs = (q == (xb.x ^ 4u)) ? c : theirs; }
    if (ok && sum == gridDim.x && xb.x < 8u) { m.j = (int)xb.x; m.rank = (int)xb.st[2] * 2 + half_; m.nb = (int)mine * 2; nbp = (int)theirs * 2; }
#endif
    m.rank4 = (m.j < 4) ? m.rank : nbp + m.rank; m.nb4 = m.nb + nbp;
    m.j = __builtin_amdgcn_readfirstlane(m.j); m.rank = __builtin_amdgcn_readfirstlane(m.rank); m.nb = __builtin_amdgcn_readfirstlane(m.nb);
    m.rank4 = __builtin_amdgcn_readfirstlane(m.rank4); m.nb4 = __builtin_amdgcn_readfirstlane(m.nb4);
    return m;
}
template <int EPI, bool NORM = false>
__device__ __forceinline__ void gemm_phase(const GemmArgs& g, const SliceMap sm, int ntm, int ntn, unsigned char* lds) {
    const int np = (ntm - sm.j + 7) >> 3, nt = np * ntn;
    for (int u = sm.rank; u < nt; u += sm.nb) gemm_tile<EPI, NORM>(g, sm.j + 8 * (u / ntn), u % ntn, lds);
}


#define G8_HT 8192
__device__ __forceinline__ int g8_lds_byte(int r, int c) { const int st = (r >> 4) * 2 + (c >> 5), rr = r & 15, cc = c & 31, ob = rr * 64 + cc * 2; return st * 1024 + (ob ^ (((ob >> 9) & 1) << 5)); }
__device__ __forceinline__ void g8_stage_rc(int b, int& R, int& C) { const int st = b / 1024, sb = b % 1024, swz = sb ^ (((sb >> 9) & 1) << 5); R = (st >> 1) * 16 + swz / 64; C = (st & 1) * 32 + (swz % 64) / 2; }
template <int EPI, bool NORM>
__device__ __forceinline__ void gemm8_tile(const GemmArgs& g, int tm, int tn, unsigned char* lds_all) {
    bf16_t* shm = (bf16_t*)lds_all;
    int tidx = threadIdx.x; asm volatile("" : "+v"(tidx));
    const int wid = __builtin_amdgcn_readfirstlane(tidx >> 6), lane = tidx & 63, wr = wid >> 2, wc = wid & 3, fr = lane & 15, fq = lane >> 4;
    const int K = g.K, nt = K >> 6;
    const bf16_t* A = g.A; const bf16_t* Bt = g.Bt;
    const long lda = g.lda, ldb = g.ldb;
    const int brow = tm * 256, bcol = tn * 256;
#define G8_SA(b, h) (shm + ((b) * 2 + (h)) * G8_HT)
#define G8_SB(b, h) (shm + (4 + (b) * 2 + (h)) * G8_HT)
    int offA_[2], offB_[2];
#pragma unroll
    for (int i_ = 0; i_ < 2; ++i_) { int r_, c_; g8_stage_rc(tidx * 16 + i_ * 8192, r_, c_); offA_[i_] = r_ * (int)lda + c_; offB_[i_] = r_ * (int)ldb + c_; }
#define G8_STAGE(P, BASE, LD, OFF, br, kt) do { const bf16_t* base_ = (BASE) + (long)(br) * (LD) + (long)(kt) * 64;        \
        _Pragma("unroll") for (int i_ = 0; i_ < 2; ++i_) \
            __builtin_amdgcn_global_load_lds((const __attribute__((address_space(1))) void*)(base_ + OFF[i_]), (LAS void*)((unsigned char*)(P) + (wid * 1024 + i_ * 8192)), 16, 0, 0); } while (0)
#define G8_LDA(dst, b, h) do { _Pragma("unroll") for (int m = 0; m < 4; ++m) _Pragma("unroll") for (int k = 0; k < 2; ++k) \
        dst[m][k] = *(const bf16x8*)((const unsigned char*)G8_SA(b, h) + g8_lds_byte(wr * 64 + m * 16 + fr, k * 32 + fq * 8)); \
        if (NORM) { _Pragma("unroll") for (int m = 0; m < 4; ++m) _Pragma("unroll") for (int k = 0; k < 2; ++k) { const u32x4 u_ = __builtin_bit_cast(u32x4, dst[m][k]); \
            const unsigned u0 = u_[0], u1 = u_[1], u2 = u_[2], u3 = u_[3]; \
            ssq[h][m] = __builtin_amdgcn_fdot2_f32_bf16(__builtin_bit_cast(bf16x2_t, u0), __builtin_bit_cast(bf16x2_t, u0), ssq[h][m], false); \
            ssq[h][m] = __builtin_amdgcn_fdot2_f32_bf16(__builtin_bit_cast(bf16x2_t, u1), __builtin_bit_cast(bf16x2_t, u1), ssq[h][m], false); \
            ssq[h][m] = __builtin_amdgcn_fdot2_f32_bf16(__builtin_bit_cast(bf16x2_t, u2), __builtin_bit_cast(bf16x2_t, u2), ssq[h][m], false); \
            ssq[h][m] = __builtin_amdgcn_fdot2_f32_bf16(__builtin_bit_cast(bf16x2_t, u3), __builtin_bit_cast(bf16x2_t, u3), ssq[h][m], false); } } } while (0)
#define G8_LDB(dst, b, h) do { _Pragma("unroll") for (int n = 0; n < 2; ++n) _Pragma("unroll") for (int k = 0; k < 2; ++k) \
        dst[n][k] = *(const bf16x8*)((const unsigned char*)G8_SB(b, h) + g8_lds_byte(wc * 32 + n * 16 + fr, k * 32 + fq * 8)); } while (0)
#define G8_MMA(ai, bj, At_, Bt_) do { __builtin_amdgcn_s_setprio(1); \
        _Pragma("unroll") for (int m = 0; m < 4; ++m) _Pragma("unroll") for (int n = 0; n < 2; ++n) _Pragma("unroll") for (int k = 0; k < 2; ++k) \
            acc[ai][bj][m][n] = __builtin_amdgcn_mfma_f32_16x16x32_bf16(Bt_[n][k], At_[m][k], acc[ai][bj][m][n], 0, 0, 0); \
        __builtin_amdgcn_s_setprio(0); } while (0)
#define G8_WAIT_V(n) asm volatile("s_waitcnt vmcnt(" #n ")" ::: "memory")
#define G8_WAIT_L(n) asm volatile("s_waitcnt lgkmcnt(" #n ")" ::: "memory")
#define G8_BAR __builtin_amdgcn_s_barrier()
#define G8_SCHED __builtin_amdgcn_sched_barrier(0)
    f32x4 acc[2][2][4][2];
#pragma unroll
    for (int a = 0; a < 2; ++a)
#pragma unroll
        for (int b = 0; b < 2; ++b)
#pragma unroll
            for (int m = 0; m < 4; ++m)
#pragma unroll
                for (int n = 0; n < 2; ++n) acc[a][b][m][n] = (f32x4){0.f, 0.f, 0.f, 0.f};
    float ssq[2][4] = {{0.f, 0.f, 0.f, 0.f}, {0.f, 0.f, 0.f, 0.f}};
    bf16x8 At[4][2], B0[2][2], B1[2][2];
    G8_WAIT_V(0);
    __syncthreads();
    G8_STAGE(G8_SB(0, 0), Bt, ldb, offB_, bcol, 0); G8_STAGE(G8_SA(0, 0), A, lda, offA_, brow, 0);
    G8_STAGE(G8_SB(0, 1), Bt, ldb, offB_, bcol + 128, 0); G8_STAGE(G8_SA(0, 1), A, lda, offA_, brow + 128, 0);
    if (wr == 1) G8_BAR;
    G8_WAIT_V(4); G8_BAR;
    G8_STAGE(G8_SB(1, 0), Bt, ldb, offB_, bcol, 1); G8_STAGE(G8_SA(1, 0), A, lda, offA_, brow, 1); G8_STAGE(G8_SB(1, 1), Bt, ldb, offB_, bcol + 128, 1);
    G8_WAIT_V(6); G8_BAR;
    for (int t = 0; t < nt - 2; t += 2) {
        G8_LDB(B0, 0, 0); G8_SCHED; G8_LDA(At, 0, 0); G8_STAGE(G8_SA(1, 1), A, lda, offA_, brow + 128, t + 1);
        G8_WAIT_L(8); G8_BAR; G8_WAIT_L(0); G8_MMA(0, 0, At, B0); G8_BAR; G8_SCHED;
        G8_LDB(B1, 0, 1); G8_STAGE(G8_SB(0, 0), Bt, ldb, offB_, bcol, t + 2);
        G8_BAR; G8_WAIT_L(0); G8_MMA(0, 1, At, B1); G8_BAR;
        G8_LDA(At, 0, 1); G8_STAGE(G8_SA(0, 0), A, lda, offA_, brow, t + 2);
        G8_BAR; G8_WAIT_L(0); G8_MMA(1, 0, At, B0); G8_BAR; G8_SCHED;
        G8_STAGE(G8_SB(0, 1), Bt, ldb, offB_, bcol + 128, t + 2);
        G8_WAIT_V(6); G8_BAR; G8_MMA(1, 1, At, B1); G8_BAR;
        G8_LDB(B0, 1, 0); G8_SCHED; G8_LDA(At, 1, 0); G8_STAGE(G8_SA(0, 1), A, lda, offA_, brow + 128, t + 2);
        G8_WAIT_L(8); G8_BAR; G8_WAIT_L(0); G8_MMA(0, 0, At, B0); G8_BAR; G8_SCHED;
        G8_LDB(B1, 1, 1); G8_STAGE(G8_SB(1, 0), Bt, ldb, offB_, bcol, t + 3);
        G8_BAR; G8_WAIT_L(0); G8_MMA(0, 1, At, B1); G8_BAR;
        G8_LDA(At, 1, 1); G8_STAGE(G8_SA(1, 0), A, lda, offA_, brow, t + 3);
        G8_BAR; G8_WAIT_L(0); G8_MMA(1, 0, At, B0); G8_BAR; G8_SCHED;
        G8_STAGE(G8_SB(1, 1), Bt, ldb, offB_, bcol + 128, t + 3);
        G8_WAIT_V(6); G8_BAR; G8_MMA(1, 1, At, B1); G8_BAR;
    }
    {
        G8_LDB(B0, 0, 0); G8_LDA(At, 0, 0); G8_STAGE(G8_SA(1, 1), A, lda, offA_, brow + 128, nt - 1);
        G8_BAR; G8_WAIT_L(0); G8_MMA(0, 0, At, B0); G8_BAR;
        G8_LDB(B1, 0, 1); G8_BAR; G8_WAIT_L(0); G8_MMA(0, 1, At, B1); G8_BAR;
        G8_LDA(At, 0, 1); G8_WAIT_V(4); G8_BAR; G8_WAIT_L(0); G8_MMA(1, 0, At, B0); G8_MMA(1, 1, At, B1); G8_BAR;
    }
    {
        G8_LDB(B0, 1, 0); G8_LDA(At, 1, 0); G8_WAIT_V(2); G8_BAR; G8_WAIT_L(0); G8_MMA(0, 0, At, B0); G8_BAR;
        G8_LDB(B1, 1, 1); G8_WAIT_V(0); G8_BAR; G8_WAIT_L(0); G8_MMA(0, 1, At, B1); G8_BAR;
        G8_LDA(At, 1, 1); G8_BAR; G8_WAIT_L(0); G8_MMA(1, 0, At, B0); G8_MMA(1, 1, At, B1); G8_BAR;
    }
    if (wr == 0) G8_BAR;
    static_assert(!NORM, "the fused-rmsnorm variant is not instantiated on the 8-phase body");
    float* stg = (float*)lds_all;
#pragma unroll
    for (int ai = 0; ai < 2; ++ai) {
        __syncthreads();
#pragma unroll
        for (int m = 0; m < 4; ++m)
#pragma unroll
            for (int bj = 0; bj < 2; ++bj)
#pragma unroll
                for (int n = 0; n < 2; ++n)
                    *(f32x4*)(stg + (wr * 64 + m * 16 + fr) * 260 + bj * 128 + wc * 32 + n * 16 + fq * 4) = acc[ai][bj][m][n];
        __syncthreads();
        const int col = bcol + lane * 4;
#pragma unroll 8
        for (int rr = 0; rr < 16; ++rr) {
            const int lr = wid * 16 + rr, row = brow + ai * 128 + lr;
            f32x4 v = *(const f32x4*)(stg + lr * 260 + lane * 4);
            if (EPI == EPI_BF16) {
                if (g.rowss) { const float t_ = g.rowss[(size_t)row * 4 + g.ss_a] + g.rowss[(size_t)row * 4 + g.ss_b]; v = v * rsqrtf(t_ / (float)K + 1e-6f); }
                if (g.colscale) { const f32x4 sc_ = *(const f32x4*)(g.colscale + col); v = v * sc_; }
                *(u32x2*)(g.C + (size_t)row * g.ldc + col) = (u32x2){cvt_pk_bf16(v[0], v[1]), cvt_pk_bf16(v[2], v[3])};
            } else {
                const f32x4 gt = *(const f32x4*)(g.gate + (size_t)(row >> 14) * g.gate_bstride + col);
                f32x4 xi;
                if (EPI == EPI_RESID) xi = *(const f32x4*)(g.xin + (size_t)row * DM + col);
                else { const u32x2 u = *(const u32x2*)(g.xs + (size_t)row * DM + col); xi = (f32x4){bf_lo(u[0]), bf_hi(u[0]), bf_lo(u[1]), bf_hi(u[1])}; }
                const f32x4 xo = xi + gt * v;
                *(u32x2*)(g.xs + (size_t)row * DM + col) = (u32x2){cvt_pk_bf16(xo[0], xo[1]), cvt_pk_bf16(xo[2], xo[3])};
            }
        }
    }
#undef G8_SA
#undef G8_SB
#undef G8_STAGE
#undef G8_LDA
#undef G8_LDB
#undef G8_MMA
#undef G8_WAIT_V
#undef G8_WAIT_L
#undef G8_BAR
#undef G8_SCHED
}
template <int EPI>
__device__ __forceinline__ void gemm8f_tile(const GemmArgs& g, int tm, int tn, unsigned char* lds_all) {
    bf16_t* shm = (bf16_t*)lds_all;
    int tidx = threadIdx.x; asm volatile("" : "+v"(tidx));
    const int wid = __builtin_amdgcn_readfirstlane(tidx >> 6), lane = tidx & 63, wr = wid >> 2, wc = wid & 3, r32 = lane & 31, hh = lane >> 5;
    const int K = g.K, nt = K >> 6;
    const bf16_t* A = g.A; const bf16_t* Bt = g.Bt;
    const long lda = g.lda, ldb = g.ldb;
    const int brow = tm * 256, bcol = tn * 256;
#define G8_SA(b, h) (shm + ((b) * 2 + (h)) * G8_HT)
#define G8_SB(b, h) (shm + (4 + (b) * 2 + (h)) * G8_HT)
    int offA_[2], offB_[2];
#pragma unroll
    for (int i_ = 0; i_ < 2; ++i_) { const int L_ = tidx + i_ * 512, r_ = L_ >> 3, c_ = ((L_ & 7) ^ ((r_ >> 1) & 7)) * 8; offA_[i_] = r_ * (int)lda + c_; offB_[i_] = r_ * (int)ldb + c_; }
#define G8_STAGE(P, BASE, LD, OFF, br, kt) do { const bf16_t* base_ = (BASE) + (long)(br) * (LD) + (long)(kt) * 64;        \
        _Pragma("unroll") for (int i_ = 0; i_ < 2; ++i_) \
            __builtin_amdgcn_global_load_lds((const __attribute__((address_space(1))) void*)(base_ + OFF[i_]), (LAS void*)((unsigned char*)(P) + (wid * 1024 + i_ * 8192)), 16, 0, 0); } while (0)
#define G8F_RD(base_, row_, c_) (*(const u32x4*)((const unsigned char*)(base_) + (row_) * 128 + ((((c_) ^ (((row_) >> 1) & 7))) << 4)))
#define G8F_CAT(lo_, hi_) __builtin_bit_cast(i32x8, __builtin_shufflevector(lo_, hi_, 0, 1, 2, 3, 4, 5, 6, 7))
#define G8_LDA(dst, b, h) do { _Pragma("unroll") for (int mm = 0; mm < 2; ++mm) _Pragma("unroll") for (int s = 0; s < 2; ++s) { const int row_ = wr * 64 + mm * 32 + r32; \
        dst[mm][s] = G8F_CAT(G8F_RD(G8_SA(b, h), row_, 4 * s + 2 * hh), G8F_RD(G8_SA(b, h), row_, 4 * s + 2 * hh + 1)); } } while (0)
#define G8_LDB(dst, b, h) do { _Pragma("unroll") for (int s = 0; s < 2; ++s) { const int row_ = wc * 32 + r32; \
        dst[s] = G8F_CAT(G8F_RD(G8_SB(b, h), row_, 4 * s + 2 * hh), G8F_RD(G8_SB(b, h), row_, 4 * s + 2 * hh + 1)); } } while (0)
#define G8_MMA(ai, bj, At_, Bt_) do { __builtin_amdgcn_s_setprio(1); \
        _Pragma("unroll") for (int mm = 0; mm < 2; ++mm) _Pragma("unroll") for (int s = 0; s < 2; ++s) \
            acc[ai][bj][mm] = __builtin_amdgcn_mfma_scale_f32_32x32x64_f8f6f4(Bt_[s], At_[mm][s], acc[ai][bj][mm], 0, 0, 0, 0, 0, 0); \
        __builtin_amdgcn_s_setprio(0); } while (0)
#define G8_WAIT_V(n) asm volatile("s_waitcnt vmcnt(" #n ")" ::: "memory")
#define G8_WAIT_L(n) asm volatile("s_waitcnt lgkmcnt(" #n ")" ::: "memory")
#define G8_BAR __builtin_amdgcn_s_barrier()
#define G8_SCHED __builtin_amdgcn_sched_barrier(0)
    f32x16 acc[2][2][2];
#pragma unroll
    for (int a = 0; a < 2; ++a)
#pragma unroll
        for (int b = 0; b < 2; ++b)
#pragma unroll
            for (int mm = 0; mm < 2; ++mm)
#pragma unroll
                for (int i = 0; i < 16; ++i) acc[a][b][mm][i] = 0.f;
    i32x8 At[2][2], B0[2], B1[2];
    G8_WAIT_V(0);
    __syncthreads();
    G8_STAGE(G8_SB(0, 0), Bt, ldb, offB_, bcol, 0); G8_STAGE(G8_SA(0, 0), A, lda, offA_, brow, 0);
    G8_STAGE(G8_SB(0, 1), Bt, ldb, offB_, bcol + 128, 0); G8_STAGE(G8_SA(0, 1), A, lda, offA_, brow + 128, 0);
    if (wr == 1) G8_BAR;
    G8_WAIT_V(4); G8_BAR;
    G8_STAGE(G8_SB(1, 0), Bt, ldb, offB_, bcol, 1); G8_STAGE(G8_SA(1, 0), A, lda, offA_, brow, 1); G8_STAGE(G8_SB(1, 1), Bt, ldb, offB_, bcol + 128, 1);
    G8_WAIT_V(6); G8_BAR;
    for (int t = 0; t < nt - 2; t += 2) {
        G8_LDB(B0, 0, 0); G8_SCHED; G8_LDA(At, 0, 0); G8_STAGE(G8_SA(1, 1), A, lda, offA_, brow + 128, t + 1);
        G8_WAIT_L(8); G8_BAR; G8_WAIT_L(0); G8_MMA(0, 0, At, B0); G8_BAR; G8_SCHED;
        G8_LDB(B1, 0, 1); G8_STAGE(G8_SB(0, 0), Bt, ldb, offB_, bcol, t + 2);
        G8_BAR; G8_WAIT_L(0); G8_MMA(0, 1, At, B1); G8_BAR;
        G8_LDA(At, 0, 1); G8_STAGE(G8_SA(0, 0), A, lda, offA_, brow, t + 2);
        G8_BAR; G8_WAIT_L(0); G8_MMA(1, 0, At, B0); G8_BAR; G8_SCHED;
        G8_STAGE(G8_SB(0, 1), Bt, ldb, offB_, bcol + 128, t + 2);
        G8_WAIT_V(6); G8_BAR; G8_MMA(1, 1, At, B1); G8_BAR;
        G8_LDB(B0, 1, 0); G8_SCHED; G8_LDA(At, 1, 0); G8_STAGE(G8_SA(0, 1), A, lda, offA_, brow + 128, t + 2);
        G8_WAIT_L(8); G8_BAR; G8_WAIT_L(0); G8_MMA(0, 0, At, B0); G8_BAR; G8_SCHED;
        G8_LDB(B1, 1, 1); G8_STAGE(G8_SB(1, 0), Bt, ldb, offB_, bcol, t + 3);
        G8_BAR; G8_WAIT_L(0); G8_MMA(0, 1, At, B1); G8_BAR;
        G8_LDA(At, 1, 1); G8_STAGE(G8_SA(1, 0), A, lda, offA_, brow, t + 3);
        G8_BAR; G8_WAIT_L(0); G8_MMA(1, 0, At, B0); G8_BAR; G8_SCHED;
        G8_STAGE(G8_SB(1, 1), Bt, ldb, offB_, bcol + 128, t + 3);
        G8_WAIT_V(6); G8_BAR; G8_MMA(1, 1, At, B1); G8_BAR;
    }
    {
        G8_LDB(B0, 0, 0); G8_LDA(At, 0, 0); G8_STAGE(G8_SA(1, 1), A, lda, offA_, brow + 128, nt - 1);
        G8_BAR; G8_WAIT_L(0); G8_MMA(0, 0, At, B0); G8_BAR;
        G8_LDB(B1, 0, 1); G8_BAR; G8_WAIT_L(0); G8_MMA(0, 1, At, B1); G8_BAR;
        G8_LDA(At, 0, 1); G8_WAIT_V(4); G8_BAR; G8_WAIT_L(0); G8_MMA(1, 0, At, B0); G8_MMA(1, 1, At, B1); G8_BAR;
    }
    {
        G8_LDB(B0, 1, 0); G8_LDA(At, 1, 0); G8_WAIT_V(2); G8_BAR; G8_WAIT_L(0); G8_MMA(0, 0, At, B0); G8_BAR;
        G8_LDB(B1, 1, 1); G8_WAIT_V(0); G8_BAR; G8_WAIT_L(0); G8_MMA(0, 1, At, B1); G8_BAR;
        G8_LDA(At, 1, 1); G8_BAR; G8_WAIT_L(0); G8_MMA(1, 0, At, B0); G8_MMA(1, 1, At, B1); G8_BAR;
    }
    if (wr == 0) G8_BAR;
    float* stg = (float*)lds_all;
    const float os = g.oscale;
#pragma unroll
    for (int ai = 0; ai < 2; ++ai) {
        __syncthreads();
#pragma unroll
        for (int mm = 0; mm < 2; ++mm)
#pragma unroll
            for (int bj = 0; bj < 2; ++bj)
#pragma unroll
                for (int q = 0; q < 4; ++q)
                    *(f32x4*)(stg + (wr * 64 + mm * 32 + r32) * 260 + bj * 128 + wc * 32 + q * 8 + hh * 4) =
                        (f32x4){acc[ai][bj][mm][4 * q] * os, acc[ai][bj][mm][4 * q + 1] * os, acc[ai][bj][mm][4 * q + 2] * os, acc[ai][bj][mm][4 * q + 3] * os};
        __syncthreads();
        const int col = bcol + lane * 4;
#pragma unroll 4
        for (int rr = 0; rr < 16; ++rr) {
            const int lr = wid * 16 + rr, row = brow + ai * 128 + lr;
            const f32x4 v = *(const f32x4*)(stg + lr * 260 + lane * 4);
            if (g.cv_from != 0 && tn >= g.cv_from) {
                const f32x4 v2 = *(const f32x4*)(stg + lr * 260 + ((lane * 4 + 128) & 255));
                if (lane < 32) *(u32x2*)(g.C + (size_t)row * g.ldc + 1024 + (tn - g.cv_from) * 128 + lane * 4) = (u32x2){cvt_pk_bf16(v[0] * v2[0], v[1] * v2[1]), cvt_pk_bf16(v[2] * v2[2], v[3] * v2[3])};
            } else
            *(u32x2*)(g.C + (size_t)row * g.ldc + col) = (u32x2){cvt_pk_bf16(v[0], v[1]), cvt_pk_bf16(v[2], v[3])};
            if (g.ssq_out != nullptr && tn <= 2) {
                float q2 = v[0] * v[0] + v[1] * v[1] + v[2] * v[2] + v[3] * v[3];
                q2 += DPPF(q2, 0xB1); q2 += DPPF(q2, 0x4E); q2 += DPPF(q2, 0x141); q2 += DPPF(q2, 0x140);
                const int qi = __float_as_int(q2);
                const float lo = __int_as_float(__builtin_amdgcn_readlane(qi, 0)) + __int_as_float(__builtin_amdgcn_readlane(qi, 16));
                const float hi = __int_as_float(__builtin_amdgcn_readlane(qi, 32)) + __int_as_float(__builtin_amdgcn_readlane(qi, 48));
                if (lane == 0) {
                    float* so = g.ssq_out + (size_t)row * 4;
                    if (tn == 0) so[0] = lo + hi; else if (tn == 1) { so[1] = lo; so[2] = hi; } else so[3] = lo;
                }
            }
        }
    }
#undef G8_SA
#undef G8_SB
#undef G8_STAGE
#undef G8_LDA
#undef G8_LDB
#undef G8F_RD
#undef G8F_CAT
#undef G8_MMA
#undef G8_WAIT_V
#undef G8_WAIT_L
#undef G8_BAR
#undef G8_SCHED
}
struct SliceMap8 { int j, rank, nb; };
template <int EPI, bool NORM>
__device__ __forceinline__ void gemm8_phase(const GemmArgs& g, const SliceMap8 s8, int ntm, int ntn, unsigned char* lds_all) {
    const int np = (ntm - s8.j + 7) >> 3, nt = np * ntn;
    for (int u = s8.rank; u < nt; u += s8.nb) gemm8_tile<EPI, NORM>(g, s8.j + 8 * (u / ntn), u % ntn, lds_all);
}
template <int EPI>
__device__ __forceinline__ void gemm8f_phase(const GemmArgs& g, const SliceMap8 s8, int ntm, int ntn, unsigned char* lds_all) {
    const int np = (ntm - s8.j + 7) >> 3, nt = np * ntn;
    for (int u = s8.rank; u < nt; u += s8.nb) gemm8f_tile<EPI>(g, s8.j + 8 * (u / ntn), u % ntn, lds_all);
}
__device__ __forceinline__ void gemm8_pair_phase(const GemmArgs& g1, int ntm1, int ntn1, const GemmArgs& g2, int ntm2, int ntn2, const SliceMap8 s8, unsigned char* lds_all) {
    const int n1 = ((ntm1 - s8.j + 7) >> 3) * ntn1, n2 = ((ntm2 - s8.j + 7) >> 3) * ntn2;
    for (int u = s8.rank; u < n1 + n2; u += s8.nb) {
        const bool first = u < n1;
        const int uu = first ? u : u - n1, ntn = first ? ntn1 : ntn2;
        gemm8_tile<EPI_BF16, false>(first ? g1 : g2, s8.j + 8 * (uu / ntn), uu % ntn, lds_all);
    }
}
__device__ __forceinline__ void latent_norm_phase(const Params& p) {
    const int tidx_ = opaque_tid();
    const int lane = tidx_ & 63, w = tidx_ >> 6;
    const bf16_t* h0 = (const bf16_t*)(p.ws + WS_R + R_H0);
    bf16_t* hqn = (bf16_t*)(p.ws + WS_R + R_HQN);
    bf16_t* ckvn = (bf16_t*)(p.ws + WS_R + R_CKVN);
    for (int row = vbid() * 4 + w; row < MROWS; row += nvb() * 4) {
        const bf16_t* hr = h0 + (size_t)row * H0LD;
        {
            const unsigned* s = (const unsigned*)(hr + lane * 6);
            const unsigned a = s[0], b = s[1], c = s[2];
            float v[6] = {bf_lo(a), bf_hi(a), bf_lo(b), bf_hi(b), bf_lo(c), bf_hi(c)};
            float ss = 0.f;
#pragma unroll
            for (int j = 0; j < 6; ++j) ss += v[j] * v[j];
            ss = wave_sum(ss);
            const float rstd = rsqrtf(ss * (1.0f / 384.0f) + 1e-6f);
            const float* gn = p.q_a_norm + lane * 6;
            unsigned* o = (unsigned*)(hqn + (size_t)row * 384 + lane * 6);
            o[0] = cvt_pk_bf16(v[0] * rstd * gn[0], v[1] * rstd * gn[1]);
            o[1] = cvt_pk_bf16(v[2] * rstd * gn[2], v[3] * rstd * gn[3]);
            o[2] = cvt_pk_bf16(v[4] * rstd * gn[4], v[5] * rstd * gn[5]);
        }
        {
            const u32x2 s = *(const u32x2*)(hr + 384 + lane * 4);
            float v[4] = {bf_lo(s[0]), bf_hi(s[0]), bf_lo(s[1]), bf_hi(s[1])};
            float ss = v[0] * v[0] + v[1] * v[1] + v[2] * v[2] + v[3] * v[3];
            ss = wave_sum(ss);
            const float rstd = rsqrtf(ss * (1.0f / 256.0f) + 1e-6f);
            const float* gn = p.kv_a_norm + lane * 4;
            *(u32x2*)(ckvn + (size_t)row * 256 + lane * 4) = (u32x2){cvt_pk_bf16(v[0] * rstd * gn[0], v[1] * rstd * gn[1]), cvt_pk_bf16(v[2] * rstd * gn[2], v[3] * rstd * gn[3])};
        }
    }
}

__device__ __forceinline__ void rope32(float* v  , int t) {
    const float inv[8] = {1.0f, 0.31622776601683794f, 0.1f, 0.031622776601683794f, 0.01f, 0.0031622776601683794f, 0.001f, 0.00031622776601683794f};
    const float pos[2] = {(float)(t >> 6), (float)(t & 63)};
#pragma unroll
    for (int a = 0; a < 2; ++a)
#pragma unroll
        for (int i = 0; i < 8; ++i) {
            const float ang = pos[a] * inv[i];
            float rev = ang * 0.15915494309189535f;
            rev = rev - floorf(rev);
            const float sn = __builtin_amdgcn_sinf(rev), cs = __builtin_amdgcn_cosf(rev);
            const float x1 = v[a * 16 + i], x2 = v[a * 16 + 8 + i];
            v[a * 16 + i] = x1 * cs - x2 * sn;
            v[a * 16 + 8 + i] = x2 * cs + x1 * sn;
        }
}

template <int W>
__device__ __forceinline__ void pool_task(const bf16_t* base, int t, bf16_t* outp) {
    u32x4 r[W];
#pragma unroll
    for (int k = 0; k < W; ++k) { int tt = t - W / 2 + k; tt = tt < 0 ? 0 : (tt > SEQ - 1 ? SEQ - 1 : tt); r[k] = *(const u32x4*)(base + (size_t)tt * H0LD); }
    float sum[8] = {0.f, 0.f, 0.f, 0.f, 0.f, 0.f, 0.f, 0.f};
    int cnt = 0;
#pragma unroll
    for (int k = 0; k < W; ++k) {
        const int tt = t - W / 2 + k;
        const bool ok = tt >= 0 && tt < SEQ;
        const float f = ok ? 1.f : 0.f; cnt += ok ? 1 : 0;
#pragma unroll
        for (int j = 0; j < 4; ++j) { sum[2 * j] += f * bf_lo(r[k][j]); sum[2 * j + 1] += f * bf_hi(r[k][j]); }
    }
    const float rc = 1.0f / (float)cnt;
    u32x4 o;
#pragma unroll
    for (int j = 0; j < 4; ++j) o[j] = cvt_pk_bf16(sum[2 * j] * rc - bf_lo(r[W / 2][j]), sum[2 * j + 1] * rc - bf_hi(r[W / 2][j]));
    *(u32x4*)outp = o;
}
#define QK_SPLIT_SCALE 0.383724440f
__device__ __forceinline__ unsigned pk4_fp8q(float a, float b, float c, float d) {
    int w = 0;
    w = __builtin_amdgcn_cvt_pk_fp8_f32(a, b, w, false);
    w = __builtin_amdgcn_cvt_pk_fp8_f32(c, d, w, true);
    return (unsigned)w;
}
__device__ __forceinline__ void norm_rope_store(const u32x4 (&c)[12], const float* gains, bool do_rope, int t, float outscale, unsigned pad96, unsigned char* dst) {
    float ss = 0.f;
#pragma unroll
    for (int cc = 0; cc < 12; ++cc)
#pragma unroll
        for (int j = 0; j < 4; ++j) { const float lo = bf_lo(c[cc][j]), hi = bf_hi(c[cc][j]); ss += lo * lo + hi * hi; }
    const float rstd = rsqrtf(ss * (1.0f / 96.0f) + 1e-6f);
    const float rs = rstd * outscale;
#pragma unroll
    for (int cc = 0; cc < 8; cc += 2) {
        u32x4 o;
#pragma unroll
        for (int h = 0; h < 2; ++h)
#pragma unroll
            for (int jj = 0; jj < 2; ++jj) {
                const unsigned u0 = c[cc + h][2 * jj], u1 = c[cc + h][2 * jj + 1];
                const int d0 = (cc + h) * 8 + 4 * jj;
                o[2 * h + jj] = pk4_fp8q(bf_lo(u0) * rs * gains[d0], bf_hi(u0) * rs * gains[d0 + 1], bf_lo(u1) * rs * gains[d0 + 2], bf_hi(u1) * rs * gains[d0 + 3]);
            }
        *(u32x4*)(dst + cc * 8) = o;
    }
    float v[32];
#pragma unroll
    for (int cc = 0; cc < 4; ++cc)
#pragma unroll
        for (int j = 0; j < 4; ++j) { v[cc * 8 + 2 * j] = bf_lo(c[8 + cc][j]) * rstd * gains[64 + cc * 8 + 2 * j]; v[cc * 8 + 2 * j + 1] = bf_hi(c[8 + cc][j]) * rstd * gains[64 + cc * 8 + 2 * j + 1]; }
    if (do_rope) rope32(v, t);
#pragma unroll
    for (int q = 0; q < 2; ++q) {
        u32x4 o;
#pragma unroll
        for (int j = 0; j < 4; ++j) o[j] = pk4_fp8q(v[q * 16 + 4 * j] * outscale, v[q * 16 + 4 * j + 1] * outscale, v[q * 16 + 4 * j + 2] * outscale, v[q * 16 + 4 * j + 3] * outscale);
        *(u32x4*)(dst + 64 + q * 16) = o;
    }
    *(u32x4*)(dst + 96) = (u32x4){pad96, 0u, 0u, 0u};
    *(u32x4*)(dst + 112) = (u32x4){0u, 0u, 0u, 0u};
}

__device__ __forceinline__ void norm_rope_store4(const u32x4 c0, const u32x4 c1, const u32x4 c2, const float* gains, bool do_rope, int t, float outscale, unsigned pad96, unsigned char* dst, int s) {
    float ss = 0.f;
#pragma unroll
    for (int j = 0; j < 4; ++j) {
        const float a0 = bf_lo(c0[j]), a1 = bf_hi(c0[j]), b0 = bf_lo(c1[j]), b1 = bf_hi(c1[j]), r0 = bf_lo(c2[j]), r1 = bf_hi(c2[j]);
        ss += a0 * a0 + a1 * a1 + b0 * b0 + b1 * b1 + r0 * r0 + r1 * r1;
    }
    ss += DPPF(ss, 0xB1); ss += DPPF(ss, 0x4E);
    const float rstd = rsqrtf(ss * (1.0f / 96.0f) + 1e-6f);
    const float rs = rstd * outscale;
    const f32x4 ga0 = *(const f32x4*)(gains + 8 * s), ga1 = *(const f32x4*)(gains + 8 * s + 4);
    const f32x4 gb0 = *(const f32x4*)(gains + 32 + 8 * s), gb1 = *(const f32x4*)(gains + 32 + 8 * s + 4);
    const f32x4 gr0 = *(const f32x4*)(gains + 64 + 8 * s), gr1 = *(const f32x4*)(gains + 64 + 8 * s + 4);
    *(u32x2*)(dst + 8 * s) = (u32x2){pk4_fp8q(bf_lo(c0[0]) * rs * ga0[0], bf_hi(c0[0]) * rs * ga0[1], bf_lo(c0[1]) * rs * ga0[2], bf_hi(c0[1]) * rs * ga0[3]),
                                     pk4_fp8q(bf_lo(c0[2]) * rs * ga1[0], bf_hi(c0[2]) * rs * ga1[1], bf_lo(c0[3]) * rs * ga1[2], bf_hi(c0[3]) * rs * ga1[3])};
    *(u32x2*)(dst + 32 + 8 * s) = (u32x2){pk4_fp8q(bf_lo(c1[0]) * rs * gb0[0], bf_hi(c1[0]) * rs * gb0[1], bf_lo(c1[1]) * rs * gb0[2], bf_hi(c1[1]) * rs * gb0[3]),
                                          pk4_fp8q(bf_lo(c1[2]) * rs * gb1[0], bf_hi(c1[2]) * rs * gb1[1], bf_lo(c1[3]) * rs * gb1[2], bf_hi(c1[3]) * rs * gb1[3])};
    float v[8];
    v[0] = bf_lo(c2[0]) * rstd * gr0[0]; v[1] = bf_hi(c2[0]) * rstd * gr0[1]; v[2] = bf_lo(c2[1]) * rstd * gr0[2]; v[3] = bf_hi(c2[1]) * rstd * gr0[3];
    v[4] = bf_lo(c2[2]) * rstd * gr1[0]; v[5] = bf_hi(c2[2]) * rstd * gr1[1]; v[6] = bf_lo(c2[3]) * rstd * gr1[2]; v[7] = bf_hi(c2[3]) * rstd * gr1[3];
    {
        const float inv[8] = {1.0f, 0.31622776601683794f, 0.1f, 0.031622776601683794f, 0.01f, 0.0031622776601683794f, 0.001f, 0.00031622776601683794f};
        const float pos = (s >> 1) ? (float)(t & 63) : (float)(t >> 6);
        const bool second = (s & 1) != 0;
#pragma unroll
        for (int i = 0; i < 8; ++i) {
            const float ang = pos * inv[i];
            float rev = ang * 0.15915494309189535f;
            rev = rev - floorf(rev);
            const float sn = __builtin_amdgcn_sinf(rev), cs = __builtin_amdgcn_cosf(rev);
            const float other = DPPF(v[i], 0xB1);
            const float rot = second ? (v[i] * cs + other * sn) : (v[i] * cs - other * sn);
            v[i] = do_rope ? rot : v[i];
        }
    }
    *(u32x2*)(dst + 64 + 8 * s) = (u32x2){pk4_fp8q(v[0] * outscale, v[1] * outscale, v[2] * outscale, v[3] * outscale), pk4_fp8q(v[4] * outscale, v[5] * outscale, v[6] * outscale, v[7] * outscale)};
    *(u32x2*)(dst + 96 + 8 * s) = (u32x2){s == 0 ? pad96 : 0u, 0u};
}

__device__ __forceinline__ void qkv_post_phase(const Params& p, unsigned char* lds) {
    const int tidx_ = opaque_tid();
    const int tid = tidx_;
    const size_t gth = (size_t)vbid() * 256 + tid, nth = (size_t)nvb() * 256;
    {
        bf16_t* Q = (bf16_t*)(p.ws + WS_R + R_Q);
        const size_t n4 = (size_t)NTOK * NHEAD * 4;
        for (size_t i4 = gth; i4 < n4; i4 += 2 * nth) {
            const size_t j4 = i4 + nth;
            const bool two = j4 < n4;
            const size_t ia = i4 >> 2, ib = (two ? j4 : i4) >> 2;
            const int sa = (int)(i4 & 3), sb = (int)((two ? j4 : i4) & 3);
            bf16_t* qa = Q + ia * QKD; bf16_t* qb = Q + ib * QKD;
            const u32x4 a0 = *(const u32x4*)(qa + sa * 8), a1 = *(const u32x4*)(qa + (sa + 4) * 8), a2 = *(const u32x4*)(qa + (sa + 8) * 8);
            const u32x4 b0 = *(const u32x4*)(qb + sb * 8), b1 = *(const u32x4*)(qb + (sb + 4) * 8), b2 = *(const u32x4*)(qb + (sb + 8) * 8);
            norm_rope_store4(a0, a1, a2, p.q_norm, true, (int)(ia >> 3) & (SEQ - 1), QK_SPLIT_SCALE, 0xC0u  , (unsigned char*)qa, sa);
            if (two) norm_rope_store4(b0, b1, b2, p.q_norm, true, (int)(ib >> 3) & (SEQ - 1), QK_SPLIT_SCALE, 0xC0u, (unsigned char*)qb, sb);
        }
    }
    {
        const bf16_t* kv = (const bf16_t*)(p.ws + WS_A0);
        const bf16_t* h0 = (const bf16_t*)(p.ws + WS_R + R_H0);
        bf16_t* K = (bf16_t*)(p.ws + WS_R + R_K);
        const size_t n4 = (size_t)MROWS * NHEAD * 4;
#define KB_ADDR(I4, ROW, HD, S_, T_, LAT, DST) const size_t i_##ROW = (I4) >> 2; const int S_ = (int)((I4) & 3); const int ROW = (int)(i_##ROW >> 3), HD = (int)(i_##ROW & 7); \
            int b_##ROW, s_##ROW, T_; bool LAT; \
            if (ROW < NTOK) { b_##ROW = ROW >> 14; T_ = ROW & (SEQ - 1); s_##ROW = CTXL + T_; LAT = true; } else { const int rc_ = ROW - NTOK; b_##ROW = rc_ >> 8; s_##ROW = rc_ & 255; T_ = 0; LAT = false; } \
            unsigned char* DST = (unsigned char*)K + ((size_t)(b_##ROW * NHEAD + HD) * SKEYS + s_##ROW) * 128; \
            const bf16_t* kn_##ROW = kv + (size_t)ROW * 1024 + HD * 128; const bf16_t* kr_##ROW = h0 + (size_t)ROW * H0LD + 640;
        for (size_t i4 = gth; i4 < n4; i4 += 2 * nth) {
            const size_t j4r = i4 + nth;
            const bool two = j4r < n4;
            const size_t j4 = two ? j4r : i4;
            KB_ADDR(i4, rowa, hda, sa, ta, lata, dsta)
            KB_ADDR(j4, rowb, hdb, sb, tb, latb, dstb)
            const u32x4 a0 = *(const u32x4*)(kn_rowa + sa * 8), a1 = *(const u32x4*)(kn_rowa + (sa + 4) * 8), a2 = *(const u32x4*)(kr_rowa + sa * 8);
            const u32x4 b0 = *(const u32x4*)(kn_rowb + sb * 8), b1 = *(const u32x4*)(kn_rowb + (sb + 4) * 8), b2 = *(const u32x4*)(kr_rowb + sb * 8);
            norm_rope_store4(a0, a1, a2, p.k_norm, lata, ta, QK_SPLIT_SCALE, 0x40u  , dsta, sa);
            if (two) norm_rope_store4(b0, b1, b2, p.k_norm, latb, tb, QK_SPLIT_SCALE, 0x40u, dstb, sb);
        }
#undef KB_ADDR
    }
    {
        const bf16_t* kv = (const bf16_t*)(p.ws + WS_A0);
        unsigned char* Vt = p.ws + WS_R + R_VT;
        bf16_t* tl = (bf16_t*)lds;
        const int ntile = 2 * NHEAD * (SKEYS / 64);
        u32x4 u0 = (u32x4){0u, 0u, 0u, 0u}, u1 = u0;
#define VT_LOAD(IT) do { const int st_ = (IT) % (SKEYS / 64), bh_ = (IT) / (SKEYS / 64), b_ = bh_ >> 3, hd_ = bh_ & 7, s0_ = st_ * 64; \
            const int row0_ = (s0_ < CTXL) ? (NTOK + b_ * CTXL + s0_) : (b_ * SEQ + s0_ - CTXL); \
            const bf16_t* src_ = kv + (size_t)(row0_ + (tid >> 2)) * 1024 + hd_ * 128 + 64 + (tid & 3) * 16; \
            u0 = *(const u32x4*)src_; u1 = *(const u32x4*)(src_ + 8); } while (0)
        if (vbid() < ntile) VT_LOAD(vbid());
        for (int it = vbid(); it < ntile; it += nvb(), tl = (tl == (bf16_t*)lds) ? (bf16_t*)lds + 64 * 72 : (bf16_t*)lds) {
            const int st = it % (SKEYS / 64), bh = it / (SKEYS / 64);
            const int s0 = st * 64;
            {
                const int key = tid >> 2, c16 = (tid & 3) * 16;
#pragma unroll
                for (int j = 0; j < 4; ++j) {
                    tl[(c16 + 2 * j) * 72 + key] = (bf16_t)(u0[j] & 0xffffu); tl[(c16 + 2 * j + 1) * 72 + key] = (bf16_t)(u0[j] >> 16);
                    tl[(c16 + 8 + 2 * j) * 72 + key] = (bf16_t)(u1[j] & 0xffffu); tl[(c16 + 8 + 2 * j + 1) * 72 + key] = (bf16_t)(u1[j] >> 16);
                }
            }
            if (it + nvb() < ntile) VT_LOAD(it + nvb());
            __syncthreads();
            {
                const int dv = tid >> 2, qd = tid & 3, h = qd >> 1, sub = qd & 1;
                u32x4 o;
#pragma unroll
                for (int g = 0; g < 2; ++g) {
                    const u32x4 v4 = *(const u32x4*)(tl + dv * 72 + 32 * sub + 16 * g + 8 * h);
                    int w0 = 0, w1 = 0;
                    w0 = __builtin_amdgcn_cvt_pk_fp8_f32(bf_lo(v4[0]), bf_hi(v4[0]), w0, false);
                    w0 = __builtin_amdgcn_cvt_pk_fp8_f32(bf_lo(v4[1]), bf_hi(v4[1]), w0, true);
                    w1 = __builtin_amdgcn_cvt_pk_fp8_f32(bf_lo(v4[2]), bf_hi(v4[2]), w1, false);
                    w1 = __builtin_amdgcn_cvt_pk_fp8_f32(bf_lo(v4[3]), bf_hi(v4[3]), w1, true);
                    o[2 * g] = (unsigned)w0; o[2 * g + 1] = (unsigned)w1;
                }
                *(u32x4*)(Vt + ((size_t)(bh * VD + dv)) * SKEYS + s0 + 16 * qd) = o;
            }
        }
        __syncthreads();
#undef VT_LOAD
    }
    {
        const bf16_t* h0 = (const bf16_t*)(p.ws + WS_R + R_H0);
        bf16_t* pooled = (bf16_t*)(p.ws + WS_R + R_HQN);
        const int lane = tid & 63, w = tid >> 6;
        for (int wt = vbid() * 4 + w; wt < (NTOK / 4) * 4; wt += nvb() * 4) {
            const int grp = wt & 3, tok = (wt >> 2) * 4 + (lane >> 4), ch = grp * 16 + (lane & 15);
            const int b = tok >> 14, t = tok & (SEQ - 1);
            const bf16_t* base = h0 + (size_t)(b * SEQ) * H0LD + 672 + ch * 8;
            bf16_t* outp = pooled + (size_t)tok * 512 + ch * 8;
            if (grp == 0) pool_task<2>(base, t, outp);
            else if (grp == 1) pool_task<4>(base, t, outp);
            else if (grp == 2) pool_task<8>(base, t, outp);
            else pool_task<16>(base, t, outp);
        }
    }
}

#define AT_KROW 128
#define AT_VROW 128
#define AT_KBUF (128 * AT_KROW)
#define AT_VBUF (64 * AT_VROW)
__device__ __forceinline__ void attention_item(const Params& p, int bh, int qblk, unsigned char* lds) {
    int tidx_ = threadIdx.x; asm volatile("" : "+v"(tidx_));
    const int tid = tidx_, lane = tid & 63, w = tid >> 6;
    const int r = lane & 31, hh = lane >> 5;
    const int b = bh >> 3, hd = bh & 7;
    const unsigned char* Q8 = p.ws + WS_R + R_Q;
    const unsigned char* Kg = p.ws + WS_R + R_K + (size_t)bh * SKEYS * 128;
    const unsigned char* Vg = p.ws + WS_R + R_VT + (size_t)bh * VD * SKEYS;
    bf16_t* outc = (bf16_t*)(p.ws + WS_R + R_H0);

    const int tok0 = b * SEQ + qblk * 512 + w * 64 + r;
    i32x8 qA0, qB0, qA1, qB1;
    {
        const unsigned char* q0 = Q8 + ((size_t)tok0 * NHEAD + hd) * (QKD * 2);
        const unsigned char* q1 = Q8 + ((size_t)(tok0 + 32) * NHEAD + hd) * (QKD * 2);
        qA0 = __builtin_bit_cast(i32x8, __builtin_shufflevector(*(const u32x4*)(q0 + 32 * hh), *(const u32x4*)(q0 + 32 * hh + 16), 0, 1, 2, 3, 4, 5, 6, 7));
        qA1 = __builtin_bit_cast(i32x8, __builtin_shufflevector(*(const u32x4*)(q1 + 32 * hh), *(const u32x4*)(q1 + 32 * hh + 16), 0, 1, 2, 3, 4, 5, 6, 7));
        qB0 = __builtin_bit_cast(i32x8, __builtin_shufflevector(*(const u32x4*)(q0 + 64 + 32 * hh), *(const u32x4*)(q0 + 80 + 32 * hh), 0, 1, 2, 3, 4, 5, 6, 7));
        qB1 = __builtin_bit_cast(i32x8, __builtin_shufflevector(*(const u32x4*)(q1 + 64 + 32 * hh), *(const u32x4*)(q1 + 80 + 32 * hh), 0, 1, 2, 3, 4, 5, 6, 7));
    }
    f32x16 O00, O01, O10, O11;
#pragma unroll
    for (int i = 0; i < 16; ++i) { O00[i] = 0.f; O01[i] = 0.f; O10[i] = 0.f; O11[i] = 0.f; }
    i32x8 onesA;
    {
        const int m_ = lane & 15;
        const int lo_ = (m_ == 0) ? 0x22222222 : 0, hi_ = (m_ == 1) ? 0x22222222 : 0;
        onesA[0] = lo_; onesA[1] = lo_; onesA[2] = hi_; onesA[3] = hi_; onesA[4] = 0; onesA[5] = 0; onesA[6] = 0; onesA[7] = 0;
    }
    f32x4 RS0 = (f32x4){0.f, 0.f, 0.f, 0.f}, RS1 = RS0;

    const int wu = __builtin_amdgcn_readfirstlane(w);
    const unsigned char* pk_[2]; const unsigned char* pv_;
#pragma unroll
    for (int i = 0; i < 2; ++i) { const int c = tid + 512 * i, row = c >> 3, ch = (c & 7) ^ ((row >> 1) & 7); pk_[i] = Kg + row * 128 + ch * 16; }
    { const int dv = tid >> 3, sl = tid & 7; pv_ = Vg + (size_t)dv * SKEYS + ((sl ^ ((dv >> 1) & 7)) * 16); }
#define AT_ISSUE(KT, BUF) do { \
        _Pragma("unroll") for (int i = 0; i < 2; ++i) { __builtin_amdgcn_global_load_lds((const __attribute__((address_space(1))) void*)pk_[i], \
                (LAS void*)(lds + (BUF) * (AT_KBUF + AT_VBUF) + (wu * 64 + 512 * i) * 16), 16, 0, 0); pk_[i] += 128 * 128; } \
        __builtin_amdgcn_global_load_lds((const __attribute__((address_space(1))) void*)pv_, (LAS void*)(lds + (BUF) * (AT_KBUF + AT_VBUF) + AT_KBUF + (wu * 64) * 16), 16, 0, 0); pv_ += 128; } while (0)
    const int krow = (r & 0x13) | ((r & 4) << 1) | ((r & 8) >> 1);
    const int NT = SKEYS / 128;
    const int kswz = (krow >> 1) & 7, vswz = (r >> 1) & 7;
#define AT_SLOT(KT_) ((KT_) % 3)
#define AT_BAR() do { __builtin_amdgcn_sched_barrier(0); __builtin_amdgcn_s_barrier(); __builtin_amdgcn_sched_barrier(0); } while (0)
#define AT_KFR(DST, SLOTBASE, SUBIDX, CH) DST = __builtin_bit_cast(i32x8, __builtin_shufflevector( \
        *(const u32x4*)((SLOTBASE) + ((SUBIDX) * 32 + krow) * AT_KROW + ((((CH)) ^ kswz) << 4)), *(const u32x4*)((SLOTBASE) + ((SUBIDX) * 32 + krow) * AT_KROW + ((((CH) + 1) ^ kswz) << 4)), 0, 1, 2, 3, 4, 5, 6, 7))
    const int grp = __builtin_amdgcn_readfirstlane(w >> 2);
    const int NP = SKEYS / 64;
    __syncthreads();
    AT_ISSUE(0, 0);
    AT_ISSUE(1, 1);
    __builtin_amdgcn_s_waitcnt(0x0F70 | 3);
    __syncthreads();
    if (grp == 1) AT_BAR();
    i32x8 v0, v1, p0, p1;
#pragma unroll
    for (int i = 0; i < 8; ++i) { v0[i] = 0; v1[i] = 0; p0[i] = 0; p1[i] = 0; }
#pragma unroll 1
    for (int p = 0; p < NP; ++p) {
        const int kt = p >> 1;
        __builtin_amdgcn_s_setprio(1);
        O00 = __builtin_amdgcn_mfma_scale_f32_32x32x64_f8f6f4(v0, p0, O00, 0, 0, 0, 0, 0, 0);
        O01 = __builtin_amdgcn_mfma_scale_f32_32x32x64_f8f6f4(v1, p0, O01, 0, 0, 0, 0, 0, 0);
        O10 = __builtin_amdgcn_mfma_scale_f32_32x32x64_f8f6f4(v0, p1, O10, 0, 0, 0, 0, 0, 0);
        O11 = __builtin_amdgcn_mfma_scale_f32_32x32x64_f8f6f4(v1, p1, O11, 0, 0, 0, 0, 0, 0);
        RS0 = __builtin_amdgcn_mfma_scale_f32_16x16x128_f8f6f4(onesA, p0, RS0, 4, 0, 0, 0, 0, 0);
        RS1 = __builtin_amdgcn_mfma_scale_f32_16x16x128_f8f6f4(onesA, p1, RS1, 4, 0, 0, 0, 0, 0);
        i32x8 kAa, kBa, kAb, kBb;
        {
            const unsigned char* kbase = lds + AT_SLOT(kt) * (AT_KBUF + AT_VBUF);
            const int s0 = (p & 1) * 2;
            AT_KFR(kAa, kbase, s0, 2 * hh); AT_KFR(kBa, kbase, s0, 4 + 2 * hh); AT_KFR(kAb, kbase, s0 + 1, 2 * hh); AT_KFR(kBb, kbase, s0 + 1, 4 + 2 * hh);
        }
        f32x16 S0a, S1a, S0b, S1b;
#pragma unroll
        for (int i = 0; i < 16; ++i) { S0a[i] = 0.f; S1a[i] = 0.f; S0b[i] = 0.f; S1b[i] = 0.f; }
        S0a = __builtin_amdgcn_mfma_scale_f32_32x32x64_f8f6f4(kAa, qA0, S0a, 0, 0, 0, 0, 0, 0);
        S1a = __builtin_amdgcn_mfma_scale_f32_32x32x64_f8f6f4(kAa, qA1, S1a, 0, 0, 0, 0, 0, 0);
        S0b = __builtin_amdgcn_mfma_scale_f32_32x32x64_f8f6f4(kAb, qA0, S0b, 0, 0, 0, 0, 0, 0);
        S1b = __builtin_amdgcn_mfma_scale_f32_32x32x64_f8f6f4(kAb, qA1, S1b, 0, 0, 0, 0, 0, 0);
        S0a = __builtin_amdgcn_mfma_scale_f32_32x32x64_f8f6f4(kBa, qB0, S0a, 0, 0, 0, 0, 0, 0);
        S1a = __builtin_amdgcn_mfma_scale_f32_32x32x64_f8f6f4(kBa, qB1, S1a, 0, 0, 0, 0, 0, 0);
        S0b = __builtin_amdgcn_mfma_scale_f32_32x32x64_f8f6f4(kBb, qB0, S0b, 0, 0, 0, 0, 0, 0);
        S1b = __builtin_amdgcn_mfma_scale_f32_32x32x64_f8f6f4(kBb, qB1, S1b, 0, 0, 0, 0, 0, 0);
        __builtin_amdgcn_s_setprio(0);
        AT_BAR();
        const bool issue = ((p & 1) == 0) && (kt + 2 < NT);
        if (issue) AT_ISSUE(kt + 2, AT_SLOT(kt + 2));
        {
            const unsigned char* vb = lds + AT_SLOT(kt) * (AT_KBUF + AT_VBUF) + AT_KBUF + r * AT_VROW;
            const int c0 = (((p & 1) * 4 + hh * 2) ^ vswz) << 4, c1 = (((p & 1) * 4 + hh * 2 + 1) ^ vswz) << 4;
            v0 = __builtin_bit_cast(i32x8, __builtin_shufflevector(*(const u32x4*)(vb + c0), *(const u32x4*)(vb + c1), 0, 1, 2, 3, 4, 5, 6, 7));
            v1 = __builtin_bit_cast(i32x8, __builtin_shufflevector(*(const u32x4*)(vb + 32 * AT_VROW + c0), *(const u32x4*)(vb + 32 * AT_VROW + c1), 0, 1, 2, 3, 4, 5, 6, 7));
        }
#pragma unroll
        for (int i = 0; i < 16; ++i) { S0a[i] = __builtin_amdgcn_exp2f(S0a[i]); S1a[i] = __builtin_amdgcn_exp2f(S1a[i]); S0b[i] = __builtin_amdgcn_exp2f(S0b[i]); S1b[i] = __builtin_amdgcn_exp2f(S1b[i]); }
#pragma unroll
        for (int d = 0; d < 4; ++d) {
            int wa0, wa1, wb0, wb1; asm volatile("" : "=v"(wa0), "=v"(wa1), "=v"(wb0), "=v"(wb1));
            wa0 = __builtin_amdgcn_cvt_pk_fp8_f32(S0a[4 * d], S0a[4 * d + 1], wa0, false); wa0 = __builtin_amdgcn_cvt_pk_fp8_f32(S0a[4 * d + 2], S0a[4 * d + 3], wa0, true);
            wa1 = __builtin_amdgcn_cvt_pk_fp8_f32(S1a[4 * d], S1a[4 * d + 1], wa1, false); wa1 = __builtin_amdgcn_cvt_pk_fp8_f32(S1a[4 * d + 2], S1a[4 * d + 3], wa1, true);
            wb0 = __builtin_amdgcn_cvt_pk_fp8_f32(S0b[4 * d], S0b[4 * d + 1], wb0, false); wb0 = __builtin_amdgcn_cvt_pk_fp8_f32(S0b[4 * d + 2], S0b[4 * d + 3], wb0, true);
            wb1 = __builtin_amdgcn_cvt_pk_fp8_f32(S1b[4 * d], S1b[4 * d + 1], wb1, false); wb1 = __builtin_amdgcn_cvt_pk_fp8_f32(S1b[4 * d + 2], S1b[4 * d + 3], wb1, true);
            p0[d] = wa0; p0[4 + d] = wb0; p1[d] = wa1; p1[4 + d] = wb1;
        }
        if ((p & 1) == 0 && kt + 1 < NT) { if (issue) __builtin_amdgcn_s_waitcnt(0x0F70 | 3); else __builtin_amdgcn_s_waitcnt(0x0F70); }
        asm volatile("s_waitcnt lgkmcnt(0)" ::: "memory");
        AT_BAR();
    }
    O00 = __builtin_amdgcn_mfma_scale_f32_32x32x64_f8f6f4(v0, p0, O00, 0, 0, 0, 0, 0, 0);
    O01 = __builtin_amdgcn_mfma_scale_f32_32x32x64_f8f6f4(v1, p0, O01, 0, 0, 0, 0, 0, 0);
    O10 = __builtin_amdgcn_mfma_scale_f32_32x32x64_f8f6f4(v0, p1, O10, 0, 0, 0, 0, 0, 0);
    O11 = __builtin_amdgcn_mfma_scale_f32_32x32x64_f8f6f4(v1, p1, O11, 0, 0, 0, 0, 0, 0);
    RS0 = __builtin_amdgcn_mfma_scale_f32_16x16x128_f8f6f4(onesA, p0, RS0, 4, 0, 0, 0, 0, 0);
    RS1 = __builtin_amdgcn_mfma_scale_f32_16x16x128_f8f6f4(onesA, p1, RS1, 4, 0, 0, 0, 0, 0);
    if (grp == 0) AT_BAR();
#undef AT_SLOT
#undef AT_BAR
#undef AT_KFR
#undef AT_ISSUE
    const float t00 = __shfl(RS0[0], r & 15), t01 = __shfl(RS0[1], r & 15), t10 = __shfl(RS1[0], r & 15), t11 = __shfl(RS1[1], r & 15);
    const float lsum0 = (r < 16) ? t00 : t01, lsum1 = (r < 16) ? t10 : t11;
    const float rl0 = 1.0f / lsum0, rl1 = 1.0f / lsum1;
    bf16_t* o0 = outc + (size_t)tok0 * 1024 + hd * 64;
    bf16_t* o1 = o0 + (size_t)32 * 1024;
#pragma unroll
    for (int g4 = 0; g4 < 4; ++g4) {
        *(u32x2*)(o0 + 8 * g4 + 4 * hh) = (u32x2){cvt_pk_bf16(O00[4 * g4] * rl0, O00[4 * g4 + 1] * rl0), cvt_pk_bf16(O00[4 * g4 + 2] * rl0, O00[4 * g4 + 3] * rl0)};
        *(u32x2*)(o0 + 32 + 8 * g4 + 4 * hh) = (u32x2){cvt_pk_bf16(O01[4 * g4] * rl0, O01[4 * g4 + 1] * rl0), cvt_pk_bf16(O01[4 * g4 + 2] * rl0, O01[4 * g4 + 3] * rl0)};
        *(u32x2*)(o1 + 8 * g4 + 4 * hh) = (u32x2){cvt_pk_bf16(O10[4 * g4] * rl1, O10[4 * g4 + 1] * rl1), cvt_pk_bf16(O10[4 * g4 + 2] * rl1, O10[4 * g4 + 3] * rl1)};
        *(u32x2*)(o1 + 32 + 8 * g4 + 4 * hh) = (u32x2){cvt_pk_bf16(O11[4 * g4] * rl1, O11[4 * g4 + 1] * rl1), cvt_pk_bf16(O11[4 * g4 + 2] * rl1, O11[4 * g4 + 3] * rl1)};
    }
}

__device__ __forceinline__ void attention_phase(const Params& p, unsigned char* lds) {
    for (int it = (int)blockIdx.x; it < 512; it += (int)gridDim.x) {
        const int xcd = it & 7, j = it >> 3;
        attention_item(p, xcd * 2 + (j >> 5), j & 31, lds);
    }
}


#ifdef PROBE_ATTN_CHECK
#ifndef ATTN_CHECK_TOL
#define ATTN_CHECK_TOL 0.10f
#endif
__device__ __forceinline__ void attn_selfcheck(const Params& p, unsigned* flag) {
    const int tidx_ = opaque_tid();
    const int lane = tidx_ & 63, w = tidx_ >> 6;
    const unsigned char* Q = p.ws + WS_R + R_Q;
    const unsigned char* K = p.ws + WS_R + R_K;
    const bf16_t* kvraw = (const bf16_t*)(p.ws + WS_A0);
    const bf16_t* outc = (const bf16_t*)(p.ws + WS_R + R_H0);
    const int gw_ = vbid() * 4 + w;
    if (gw_ >= 512) return;
    const int b = gw_ & 1, hd = (gw_ >> 1) & 7, t = ((gw_ >> 4) * 523 + (gw_ & 15) * 37 + 5) & (SEQ - 1);
    const int tok = b * SEQ + t;
    const unsigned char* q = Q + ((size_t)tok * NHEAD + hd) * (QKD * 2);
    const unsigned char* Kb = K + (size_t)(b * NHEAD + hd) * SKEYS * 128;
    float qv[96];
#pragma unroll
    for (int d = 0; d < 96; ++d) qv[d] = __builtin_amdgcn_cvt_f32_fp8((int)q[d], 0);
    float o = 0.f, l = 0.f;
    for (int s0 = 0; s0 < SKEYS; s0 += 64) {
        const unsigned char* kr = Kb + (size_t)(s0 + lane) * 128;
        float sc = 0.f;
#pragma unroll
        for (int d = 0; d < 96; ++d) sc += qv[d] * __builtin_amdgcn_cvt_f32_fp8((int)kr[d], 0);
        const float pr = exp2f(sc);
        l += pr;
        for (int kk = 0; kk < 64; ++kk) {
            const float pk = __shfl(pr, kk);
            const int sk = s0 + kk, vrow = (sk < CTXL) ? (NTOK + b * CTXL + sk) : (b * SEQ + sk - CTXL);
            o += pk * bf2f(kvraw[(size_t)vrow * 1024 + hd * 128 + 64 + lane]);
        }
    }
    l = wave_sum(l);
    const float ref = o / l;
    const float got = bf2f(outc[(size_t)tok * 1024 + hd * 64 + lane]);
    const float en = wave_sum((got - ref) * (got - ref)), rn = wave_sum(ref * ref);
    if (!(en <= ATTN_CHECK_TOL * ATTN_CHECK_TOL * rn + 1e-12f) && lane == 0) atomicAdd(flag, 1u);
}
#endif

#ifdef PROBE_QK_CHECK
__device__ __forceinline__ void qk_selfcheck(const Params& p, unsigned* flag) {
    const int tidx_ = opaque_tid();
    const int lane = tidx_ & 63, w = tidx_ >> 6;
    const int gwv = vbid() * 4 + w;
    if (gwv >= 512) return;
    const bf16_t* h0 = (const bf16_t*)(p.ws + WS_R + R_H0);
    const unsigned char* Qb = p.ws + WS_R + R_Q;
    const unsigned char* Kb = p.ws + WS_R + R_K;
    const int hd = gwv & 7;
    const bool isk = (gwv >> 3) & 1;
    int row = ((gwv >> 4) * 1031 + 77) % NTOK;
    if (isk && (gwv >> 4) % 4 == 3) row = NTOK + ((gwv >> 4) * 13) % 512;
    const bf16_t* hr = h0 + (size_t)row * H0LD;
    float val[2] = {0.f, 0.f};
    if (!isk) {
        float ss = 0.f;
        for (int k = lane; k < 384; k += 64) { const float v = bf2f(hr[k]); ss += v * v; }
        ss = wave_sum(ss);
        const float rstd = rsqrtf(ss / 384.f + 1e-6f);
        for (int k = 0; k < 384; ++k) {
            const float a = bf2f(hr[k]) * rstd * p.q_a_norm[k];
            val[0] += a * p.q_b_w[(size_t)k * 768 + hd * 96 + lane];
            if (lane < 32) val[1] += a * p.q_b_w[(size_t)k * 768 + hd * 96 + 64 + lane];
        }
    } else {
        float ss = 0.f;
        for (int k = lane; k < 256; k += 64) { const float v = bf2f(hr[384 + k]); ss += v * v; }
        ss = wave_sum(ss);
        const float rstd = rsqrtf(ss / 256.f + 1e-6f);
        for (int k = 0; k < 256; ++k) {
            const float a = bf2f(hr[384 + k]) * rstd * p.kv_a_norm[k];
            val[0] += a * p.kv_b_w[(size_t)k * 1024 + hd * 128 + lane];
        }
        if (lane < 32) val[1] = bf2f(hr[640 + lane]);
    }
    float ss2 = val[0] * val[0] + ((lane < 32) ? val[1] * val[1] : 0.f);
    ss2 = wave_sum(ss2);
    const float r2 = rsqrtf(ss2 / 96.f + 1e-6f);
    const float* gn = isk ? p.k_norm : p.q_norm;
    val[0] = val[0] * r2 * gn[lane];
    if (lane < 32) val[1] = val[1] * r2 * gn[64 + lane];
    const bool lat = row < NTOK;
    if (lat) {
        const int t = row & (SEQ - 1);
        const int d = lane & 31, a = d >> 4, within = d & 15, half = within >> 3, i = within & 7;
        const float pos = (a == 0) ? (float)(t / 64) : (float)(t % 64);
        const float inv = powf(10000.0f, -(float)(2 * i) / 16.0f);
        float sn, cs; sincosf(pos * inv, &sn, &cs);
        const float mine = val[1];
        const float other = __shfl(val[1], (lane & 32) | (a * 16 + (half ? i : 8 + i)));
        const float rot = half == 0 ? mine * cs - other * sn : mine * cs + other * sn;
        if (lane < 32) val[1] = rot;
    }
    const float qs = QK_SPLIT_SCALE;
    const unsigned char* got;
    if (!isk) got = Qb + ((size_t)row * NHEAD + hd) * (QKD * 2);
    else { int b, sidx; if (lat) { b = row >> 14; sidx = CTXL + (row & (SEQ - 1)); } else { const int rc = row - NTOK; b = rc >> 8; sidx = rc & 255; } got = Kb + ((size_t)(b * NHEAD + hd) * SKEYS + sidx) * 128; }
    const float r0 = val[0] * qs, g0 = __builtin_amdgcn_cvt_f32_fp8((int)got[lane], 0);
    bool bad = !(fabsf(g0 - r0) <= 0.09f * fabsf(r0) + 0.03f * qs);
    if (lane < 32) { const float r1 = val[1] * qs, g1 = __builtin_amdgcn_cvt_f32_fp8((int)got[64 + lane], 0); bad = bad || !(fabsf(g1 - r1) <= 0.09f * fabsf(r1) + 0.03f * qs); }
    if (bad) atomicAdd(flag, 1u);
}
#endif
__device__ __forceinline__ void conv_phase(const Params& p) {
    const int tidx_ = opaque_tid();
    const bf16_t* h1 = (const bf16_t*)(p.ws + WS_R + R_H1);
    bf16_t* z = (bf16_t*)(p.ws + WS_R + R_Z);
    const size_t gth = (size_t)vbid() * 256 + tidx_, nth = (size_t)nvb() * 256;
    for (size_t i = gth; i < (size_t)(NTOK / 4) * 128; i += nth) {
        const int tok0 = (int)(i >> 7) * 4, ch = (int)(i & 127) * 8;
        const int t0 = tok0 & (SEQ - 1);
        const bf16_t* hb = h1 + (size_t)(tok0 - t0) * 3072 + ch;
        u32x4 cg[6], bg[4];
#pragma unroll
        for (int k = 0; k < 6; ++k) { int tt = t0 - 1 + k; tt = tt < 0 ? 0 : (tt > SEQ - 1 ? SEQ - 1 : tt); cg[k] = *(const u32x4*)(hb + (size_t)tt * 3072 + 1024); }
#pragma unroll
        for (int m = 0; m < 4; ++m) bg[m] = *(const u32x4*)(hb + (size_t)(t0 + m) * 3072);
        const f32x4 wa0 = *(const f32x4*)(p.c_conv + ch), wa1 = *(const f32x4*)(p.c_conv + ch + 4);
        const f32x4 wb0 = *(const f32x4*)(p.c_conv + 1024 + ch), wb1 = *(const f32x4*)(p.c_conv + 1024 + ch + 4);
        const f32x4 wc0 = *(const f32x4*)(p.c_conv + 2048 + ch), wc1 = *(const f32x4*)(p.c_conv + 2048 + ch + 4);
        float u[6][8];
#pragma unroll
        for (int k = 0; k < 6; ++k) {
            const int tt = t0 - 1 + k;
            const float f = (tt >= 0 && tt < SEQ) ? 1.f : 0.f;
#pragma unroll
            for (int j = 0; j < 4; ++j) { u[k][2 * j] = f * bf_lo(cg[k][j]); u[k][2 * j + 1] = f * bf_hi(cg[k][j]); }
        }
#pragma unroll
        for (int m = 0; m < 4; ++m) {
            u32x4 o;
#pragma unroll
            for (int j = 0; j < 4; ++j) {
                const float w0a = (j < 2) ? wa0[2 * j] : wa1[2 * j - 4], w0b = (j < 2) ? wa0[2 * j + 1] : wa1[2 * j - 3];
                const float w1a = (j < 2) ? wb0[2 * j] : wb1[2 * j - 4], w1b = (j < 2) ? wb0[2 * j + 1] : wb1[2 * j - 3];
                const float w2a = (j < 2) ? wc0[2 * j] : wc1[2 * j - 4], w2b = (j < 2) ? wc0[2 * j + 1] : wc1[2 * j - 3];
                const float ca = u[m][2 * j] * w0a + u[m + 1][2 * j] * w1a + u[m + 2][2 * j] * w2a;
                const float cb = u[m][2 * j + 1] * w0b + u[m + 1][2 * j + 1] * w1b + u[m + 2][2 * j + 1] * w2b;
                o[j] = cvt_pk_bf16(bf_lo(bg[m][j]) * ca, bf_hi(bg[m][j]) * cb);
            }
            *(u32x4*)(z + (size_t)(tok0 + m) * 1024 + ch) = o;
        }
    }
}

#define TK_LD 260
#define CE_D(a, b) do { const float t_ = fmaxf(a, b); b = fminf(a, b); a = t_; } while (0)
__device__ __forceinline__ void sort16_desc(float (&v)[16]) {
    CE_D(v[0], v[13]); CE_D(v[1], v[12]); CE_D(v[2], v[15]); CE_D(v[3], v[14]); CE_D(v[4], v[8]); CE_D(v[5], v[6]); CE_D(v[7], v[11]); CE_D(v[9], v[10]);
    CE_D(v[0], v[5]); CE_D(v[1], v[7]); CE_D(v[2], v[9]); CE_D(v[3], v[4]); CE_D(v[6], v[13]); CE_D(v[8], v[14]); CE_D(v[10], v[15]); CE_D(v[11], v[12]);
    CE_D(v[0], v[1]); CE_D(v[2], v[3]); CE_D(v[4], v[5]); CE_D(v[6], v[8]); CE_D(v[7], v[9]); CE_D(v[10], v[11]); CE_D(v[12], v[13]); CE_D(v[14], v[15]);
    CE_D(v[0], v[2]); CE_D(v[1], v[3]); CE_D(v[4], v[10]); CE_D(v[5], v[11]); CE_D(v[6], v[7]); CE_D(v[8], v[9]); CE_D(v[12], v[14]); CE_D(v[13], v[15]);
    CE_D(v[1], v[2]); CE_D(v[3], v[12]); CE_D(v[4], v[6]); CE_D(v[5], v[7]); CE_D(v[8], v[10]); CE_D(v[9], v[11]); CE_D(v[13], v[14]);
    CE_D(v[1], v[4]); CE_D(v[2], v[6]); CE_D(v[5], v[8]); CE_D(v[7], v[10]); CE_D(v[9], v[13]); CE_D(v[11], v[14]);
    CE_D(v[2], v[4]); CE_D(v[3], v[6]); CE_D(v[9], v[12]); CE_D(v[11], v[13]);
    CE_D(v[3], v[5]); CE_D(v[6], v[8]); CE_D(v[7], v[9]); CE_D(v[10], v[12]);
    CE_D(v[3], v[4]); CE_D(v[5], v[6]); CE_D(v[7], v[8]); CE_D(v[9], v[10]); CE_D(v[11], v[12]);
    CE_D(v[6], v[7]); CE_D(v[8], v[9]);
}
__device__ __forceinline__ void merge_top16(float (&a)[16], const float (&b)[16]) {
#pragma unroll
    for (int i = 0; i < 16; ++i) a[i] = fmaxf(a[i], b[15 - i]);
#pragma unroll
    for (int j = 8; j >= 1; j >>= 1)
#pragma unroll
        for (int i = 0; i < 16; ++i) { const int l = i ^ j; if (l > i) CE_D(a[i], a[l]); }
}
__device__ __forceinline__ float tk_val(float x) { return __uint_as_float(__float_as_uint(x) & ~127u); }
__device__ __forceinline__ void peer_topk_phase(const Params& p, int layer, const bf16_t* qp, int* eid, float* gw, unsigned char* lds) {
    const int tidx_ = opaque_tid();
    const int tid = tidx_, lane = tid & 63, w = tid >> 6;
    const int lr = lane & 15, lg = lane >> 4;
    float* sc = (float*)lds;
    float* lst = (float*)(lds + 64 * TK_LD * 4);
    const bf16_t* keys = (const bf16_t*)(p.ws + WS_KEYS) + (size_t)layer * 8 * 2 * 128 * 64;
    const int hsel = vbid() & 1, cwv = hsel ? 3 : 0;
    bf16x8 af[2][4], bfr[2][4];
    int hd_cur = -1;
#define TK_LDQ(IT) do { const bf16_t* qa_ = qp + (size_t)(((IT) >> 3) * 64 + lr) * 1024 + ((IT) & 7) * 128 + (w >> 1) * 64 + lg * 8; \
        _Pragma("unroll") for (int ks_ = 0; ks_ < 2; ++ks_) _Pragma("unroll") for (int i_ = 0; i_ < 4; ++i_) af[ks_][i_] = *(const bf16x8*)(qa_ + (size_t)i_ * 16 * 1024 + ks_ * 32); } while (0)
    if (vbid() < 512 * 8) TK_LDQ(vbid());
    for (int it = vbid(); it < 512 * 8; it += nvb()) {
        const int hd = it & 7, tt = it >> 3, tok0 = tt * 64;
        {
            const int side = w >> 1, half = w & 1;
            f32x4 acc[4][4];
#pragma unroll
            for (int i = 0; i < 4; ++i)
#pragma unroll
                for (int j = 0; j < 4; ++j) acc[i][j] = (f32x4){0.f, 0.f, 0.f, 0.f};
            if (hd != hd_cur) {
                hd_cur = hd;
                const bf16_t* kb = keys + ((size_t)(hd * 2 + side) * 128 + half * 64 + lr) * 64 + lg * 8;
#pragma unroll
                for (int ks = 0; ks < 2; ++ks)
#pragma unroll
                    for (int i = 0; i < 4; ++i) bfr[ks][i] = *(const bf16x8*)(kb + i * 16 * 64 + ks * 32);
            }
#pragma unroll
            for (int ks = 0; ks < 2; ++ks)
#pragma unroll
                for (int i = 0; i < 4; ++i)
#pragma unroll
                    for (int j = 0; j < 4; ++j) acc[i][j] = __builtin_amdgcn_mfma_f32_16x16x32_bf16(bfr[ks][j], af[ks][i], acc[i][j], 0, 0, 0);
            if (it + nvb() < 512 * 8) TK_LDQ(it + nvb());
#pragma unroll
            for (int i = 0; i < 4; ++i)
#pragma unroll
                for (int j = 0; j < 4; ++j) *(f32x4*)(sc + (i * 16 + lr) * TK_LD + side * 128 + half * 64 + j * 16 + lg * 4) = acc[i][j];
        }
        __syncthreads();
        {
            const int lane_ = tid & 63, wv_ = tid >> 6;
            const int token = (wv_ & 1) * 32 + (lane_ & 31), side = wv_ >> 1, half = lane_ >> 5;
            const float* s = sc + token * TK_LD + side * 128 + half * 64;
            float m0[16], g1[16], g2[16], g3[16];
#pragma unroll
            for (int k4 = 0; k4 < 4; ++k4) {
                const f32x4 a = *(const f32x4*)(s + k4 * 4), b = *(const f32x4*)(s + 16 + k4 * 4), c = *(const f32x4*)(s + 32 + k4 * 4), d = *(const f32x4*)(s + 48 + k4 * 4);
#pragma unroll
                for (int e = 0; e < 4; ++e) {
                    const unsigned ix = (unsigned)(half * 64 + k4 * 4 + e);
                    m0[k4 * 4 + e] = __uint_as_float((__float_as_uint(a[e]) & ~127u) | ix);
                    g1[k4 * 4 + e] = __uint_as_float((__float_as_uint(b[e]) & ~127u) | (ix + 16u));
                    g2[k4 * 4 + e] = __uint_as_float((__float_as_uint(c[e]) & ~127u) | (ix + 32u));
                    g3[k4 * 4 + e] = __uint_as_float((__float_as_uint(d[e]) & ~127u) | (ix + 48u));
                }
            }
            sort16_desc(m0); sort16_desc(g1); sort16_desc(g2); sort16_desc(g3);
            merge_top16(m0, g1); merge_top16(g2, g3); merge_top16(m0, g2);
            float x[16], y[16];
#pragma unroll
            for (int q = 0; q < 16; ++q) {
                const auto r_ = __builtin_amdgcn_permlane32_swap(__float_as_uint(m0[q]), __float_as_uint(m0[q]), false, false);
                const unsigned r0_ = r_[0], r1_ = r_[1];
                x[q] = __uint_as_float(r0_); y[q] = __uint_as_float(r1_);
            }
            merge_top16(x, y);
            if (half == 0) {
                float* o = lst + (token * 2 + side) * 16;
#pragma unroll
                for (int q = 0; q < 4; ++q) *(f32x4*)(o + q * 4) = (f32x4){x[q * 4], x[q * 4 + 1], x[q * 4 + 2], x[q * 4 + 3]};
            }
        }
        __syncthreads();
        if ((tid >> 6) == cwv) {
            const int token = tid & 63;
            float v1[16], v2[16];
#pragma unroll
            for (int q = 0; q < 4; ++q) {
                const f32x4 u = *(const f32x4*)(lst + (token * 2) * 16 + q * 4), v = *(const f32x4*)(lst + (token * 2 + 1) * 16 + q * 4);
#pragma unroll
                for (int e = 0; e < 4; ++e) { v1[q * 4 + e] = tk_val(u[e]); v2[q * 4 + e] = tk_val(v[e]); }
            }
#define TK_CAND(I, J) __uint_as_float((__float_as_uint(v1[I] + v2[J]) & ~255u) | (unsigned)(255 - (16 * (I) + (J))))
            float T[16], R[16];
#pragma unroll
            for (int j = 0; j < 16; ++j) T[j] = TK_CAND(0, j);
#pragma unroll
            for (int j = 0; j < 16; ++j) R[j] = (j < 8) ? TK_CAND(1, j & 7) : -3.0e38f;
            merge_top16(T, R);
            R[0] = TK_CAND(2, 0); R[1] = TK_CAND(2, 1); R[2] = TK_CAND(2, 2); R[3] = TK_CAND(2, 3); R[4] = TK_CAND(2, 4);
            R[5] = TK_CAND(3, 0); R[6] = TK_CAND(3, 1); R[7] = TK_CAND(3, 2); R[8] = TK_CAND(3, 3);
            R[9] = TK_CAND(4, 0); R[10] = TK_CAND(4, 1); R[11] = TK_CAND(4, 2);
            R[12] = -3.0e38f; R[13] = -3.0e38f; R[14] = -3.0e38f; R[15] = -3.0e38f;
            sort16_desc(R); merge_top16(T, R);
            R[0] = TK_CAND(5, 0); R[1] = TK_CAND(5, 1); R[2] = TK_CAND(6, 0); R[3] = TK_CAND(6, 1); R[4] = TK_CAND(7, 0); R[5] = TK_CAND(7, 1);
            R[6] = TK_CAND(8, 0); R[7] = TK_CAND(9, 0); R[8] = TK_CAND(10, 0); R[9] = TK_CAND(11, 0); R[10] = TK_CAND(12, 0); R[11] = TK_CAND(13, 0);
            R[12] = TK_CAND(14, 0); R[13] = TK_CAND(15, 0); R[14] = -3.0e38f; R[15] = -3.0e38f;
            sort16_desc(R); merge_top16(T, R);
#undef TK_CAND
            const float m = T[0];
            float e[16], sum = 0.f;
#pragma unroll
            for (int j = 0; j < 16; ++j) { e[j] = __expf(T[j] - m); sum += e[j]; }
            const float rs = 1.0f / sum;
            int* eo = eid + (size_t)(tok0 + token) * 128 + hd * 16;
            float* go = gw + (size_t)(tok0 + token) * 128 + hd * 16;
            int ev[16];
#pragma unroll
            for (int j = 0; j < 16; ++j) {
                const unsigned pl = 255u - (__float_as_uint(T[j]) & 255u);
                const unsigned i1 = __float_as_uint(lst[(token * 2) * 16 + (pl >> 4)]) & 127u;
                const unsigned i2 = __float_as_uint(lst[(token * 2 + 1) * 16 + (pl & 15u)]) & 127u;
                ev[j] = (int)(i1 * 128u + i2);
            }
#pragma unroll
            for (int q = 0; q < 4; ++q) {
                *(u32x4*)(eo + q * 4) = (u32x4){(unsigned)ev[q * 4], (unsigned)ev[q * 4 + 1], (unsigned)ev[q * 4 + 2], (unsigned)ev[q * 4 + 3]};
                *(f32x4*)(go + q * 4) = (f32x4){e[q * 4] * rs, e[q * 4 + 1] * rs, e[q * 4 + 2] * rs, e[q * 4 + 3] * rs};
            }
        }
    }
    __syncthreads();
#undef TK_LDQ
}

__device__ __forceinline__ int dpp_xor1(int v) { return __builtin_amdgcn_update_dpp(0, v, 0xB1, 0xf, 0xf, true); }
__device__ __forceinline__ int dpp_xor2(int v) { return __builtin_amdgcn_update_dpp(0, v, 0x4E, 0xf, 0xf, true); }
__device__ __forceinline__ int dpp_hmir(int v) { return __builtin_amdgcn_update_dpp(0, v, 0x141, 0xf, 0xf, true); }
__device__ __forceinline__ void peer_u_phase(const Params& p, const SliceMap sm, int layer, const int* eid, float* pa) {
    const int tidx_ = opaque_tid();
    const int lane = tidx_ & 63, w = __builtin_amdgcn_readfirstlane(tidx_ >> 6), sub = lane >> 3, ch = lane & 7;
    const int j = sm.j & 3, rank = sm.rank4, nb = sm.nb4;
    const unsigned char* U4 = p.ws + WS_UTAB + ((size_t)(layer * 4 + j) * NEXP) * 128 + ch * 16;
    const unsigned char* X8 = p.ws + WS_XQ8 + (size_t)j * NTOK * 256 + ch * 32;
    const float* SX = (const float*)(p.ws + WS_SX) + (size_t)j * NTOK;
    const int* eidl = eid + sub * 16;
    float* paj = pa + (size_t)j * NTOK * 128 + sub * 16 + ch;
    const int stride = nb * 4;
    const int tfirst = rank * 4 + w;
    if (tfirst >= NTOK) return;
    const int niter = (NTOK - 1 - tfirst) / stride + 1, tlast = tfirst + (niter - 1) * stride;
    u32x4 EA[4], EB[4], XAl, XAh, XBl, XBh, BA[16], BB[16];
    float sA, sB;
#define U_S1E(T, E_) do { _Pragma("unroll") for (int q = 0; q < 4; ++q) E_[q] = *(const u32x4*)(eidl + (size_t)(T) * 128 + q * 4); } while (0)
#define U_S1X(T, Xl_, Xh_, S_) do { Xl_ = *(const u32x4*)(X8 + (size_t)(T) * 256); Xh_ = *(const u32x4*)(X8 + (size_t)(T) * 256 + 16); S_ = SX[(T)]; } while (0)
#define U_S2(E_, B_) do { _Pragma("unroll") for (int it = 0; it < 16; ++it) B_[it] = *(const u32x4*)(U4 + (size_t)E_[it >> 2][it & 3] * 128); } while (0)
#define U_S3(T, VALID, Xl_, Xh_, S_, B_, EN_) do { \
        int r0_ = 0, r1_ = 0; \
        _Pragma("unroll") for (int it = 0; it < 16; ++it) { \
            int al_ = 0, ah_ = 0; \
            _Pragma("unroll") for (int q = 0; q < 4; ++q) { al_ = __builtin_amdgcn_sdot8((int)B_[it][q], (int)Xl_[q], al_, false); ah_ = __builtin_amdgcn_sdot8((int)B_[it][q], (int)Xh_[q], ah_, false); } \
            int a_ = al_ + (ah_ << 4); \
            B_[it] = *(const u32x4*)(U4 + (size_t)EN_[it >> 2][it & 3] * 128); \
            a_ += dpp_xor1(a_); a_ += dpp_xor2(a_); a_ += dpp_hmir(a_); \
            if (it < 8) r0_ = (ch == it) ? a_ : r0_; else r1_ = (ch == it - 8) ? a_ : r1_; } \
        if (VALID) { paj[(size_t)(T) * 128] = (float)r0_ * S_; paj[(size_t)(T) * 128 + 8] = (float)r1_ * S_; } \
    } while (0)
#define U_CL(T) ((T) < tlast ? (T) : tlast)
    int t0 = tfirst;
    U_S1E(t0, EA); U_S1X(t0, XAl, XAh, sA);
    { const int t1 = U_CL(t0 + stride); U_S1E(t1, EB); U_S1X(t1, XBl, XBh, sB); }
    U_S2(EA, BA);
    U_S2(EB, BB);
    { const int t2 = U_CL(t0 + 2 * stride), t3 = U_CL(t0 + 3 * stride); U_S1E(t2, EA); U_S1E(t3, EB); }
    for (int it2 = 0; it2 < niter; it2 += 2) {
        const int t1 = U_CL(t0 + stride), t2 = U_CL(t0 + 2 * stride), t3 = U_CL(t0 + 3 * stride), t4 = U_CL(t0 + 4 * stride), t5 = U_CL(t0 + 5 * stride);
        U_S3(t0, true, XAl, XAh, sA, BA, EA);
        U_S1X(t2, XAl, XAh, sA);
        U_S1E(t4, EA);
        U_S3(t1, (it2 + 1 < niter), XBl, XBh, sB, BB, EB);
        U_S1X(t3, XBl, XBh, sB);
        U_S1E(t5, EB);
        t0 += 2 * stride;
    }
#undef U_S1E
#undef U_S1X
#undef U_S2
#undef U_S3
#undef U_CL
}
__device__ __forceinline__ void peer_c_phase(const Params& p, int layer, const float* pa, const int* eid, float* gw) {
    const int tidx_ = opaque_tid();
    const size_t nth = (size_t)nvb() * 256, N = (size_t)NTOK * 128;
    const f32x2* suv = (const f32x2*)(p.ws + WS_SV) + (size_t)layer * NEXP;
    for (size_t i0 = ((size_t)vbid() * 256 + tidx_) * 4; i0 < N; i0 += 4 * nth) {
        const u32x4 e4 = *(const u32x4*)(eid + i0);
        const f32x4 g4 = *(const f32x4*)(gw + i0);
        const f32x4 s4 = (*(const f32x4*)(pa + i0) + *(const f32x4*)(pa + N + i0)) + (*(const f32x4*)(pa + 2 * N + i0) + *(const f32x4*)(pa + 3 * N + i0));
        f32x2 sc2[4];
#pragma unroll
        for (int u = 0; u < 4; ++u) sc2[u] = suv[e4[u]];
        u32x4 o;
#pragma unroll
        for (int u = 0; u < 4; ++u) {
            const float a = s4[u] * sc2[u][0];
            const float cf = g4[u] * 0.5f * a * (1.0f + erff(a * 0.70710678118654752f)) * sc2[u][1];
            const _Float16 ch = (_Float16)cf;
            o[u] = ((unsigned)__builtin_bit_cast(unsigned short, ch) << 16) | e4[u];
        }
        *(u32x4*)((unsigned*)gw + i0) = o;
    }
}
__device__ __forceinline__ void swap32_add(float& a, float& b) {
    const auto r = __builtin_amdgcn_permlane32_swap(__float_as_uint(a), __float_as_uint(b), false, false);
    const unsigned r0 = r[0], r1 = r[1];
    a = __uint_as_float(r0) + __uint_as_float(r1);
}
__device__ __forceinline__ void swap16_add(float& a, float& b) {
    const auto r = __builtin_amdgcn_permlane16_swap(__float_as_uint(a), __float_as_uint(b), false, false);
    const unsigned r0 = r[0], r1 = r[1];
    a = __uint_as_float(r0) + __uint_as_float(r1);
}
template <bool LAST>
__device__ __forceinline__ void peer_v_phase(const Params& p, const SliceMap sm, int layer, const unsigned* cep, bf16_t* xs, float* xout) {
    const int tidx_ = opaque_tid();
    const int lane = tidx_ & 63, w = __builtin_amdgcn_readfirstlane(tidx_ >> 6), sub = lane >> 3, ch = lane & 7, rw = lane >> 4;
    const int j = sm.j & 3, rank = sm.rank4, nb = sm.nb4;
    const unsigned char* V4 = p.ws + WS_VTAB + ((size_t)(layer * 4 + j) * NEXP) * 128 + ch * 16;
    const float* modv = (const float*)(p.ws + WS_MODV) + (size_t)layer * 3 * 6144 + 5 * 1024 + j * 256 + ch * 32 + rw * 8;
    const __amdgpu_buffer_rsrc_t xrs = __builtin_amdgcn_make_buffer_rsrc(xs, 0, NTOK * DM * 2, 0x00020000);
    const __amdgpu_buffer_rsrc_t ors = __builtin_amdgcn_make_buffer_rsrc(xout, 0, NTOK * DM * 4, 0x00020000);
    const unsigned x_lane = ((lane & 8) == 0) ? (unsigned)((j * 256 + ch * 32 + rw * 8) * 2) : 0xffffffffu;
    const unsigned o_lane = ((lane & 8) == 0) ? (unsigned)((j * 256 + ch * 32 + rw * 8) * 4) : 0xffffffffu;
    const unsigned* cepl = cep + sub * 16;
    const int stride = nb * 4;
    const int tfirst = rank * 4 + w;
    if (tfirst >= NTOK) return;
    const int niter = (NTOK - 1 - tfirst) / stride + 1, tlast = tfirst + (niter - 1) * stride;
    u32x4 C0[4], C1[4], C2[4], HA[8], HB[8];
#define V_IDS(T, C_) do { _Pragma("unroll") for (int q = 0; q < 4; ++q) C_[q] = *(const u32x4*)(cepl + (size_t)(T) * 128 + q * 4); } while (0)
#define V_LOADH(HH, C_, H8) do { _Pragma("unroll") for (int it = 0; it < 8; ++it) HH[it] = *(const u32x4*)(V4 + (size_t)(C_[(H8) * 2 + (it >> 2)][it & 3] & 0xffffu) * 128); } while (0)
#define V_COMP(HH, C_, H8) do { _Pragma("unroll") for (int it = 0; it < 8; ++it) { \
            const unsigned rec_ = C_[(H8) * 2 + (it >> 2)][it & 3]; const _Float16 ch_ = __builtin_bit_cast(h16x2, rec_)[1]; \
            const h16x2 c2_ = {ch_, ch_}; \
            _Pragma("unroll") for (int q = 0; q < 4; ++q) { \
                const unsigned w_ = HH[it][q]; \
                acc2[4 * q]     = __builtin_elementwise_fma(__builtin_bit_cast(h16x2, __builtin_amdgcn_cvt_scalef32_pk_f16_fp4(w_, 1.0f, 0)), c2_, acc2[4 * q]); \
                acc2[4 * q + 1] = __builtin_elementwise_fma(__builtin_bit_cast(h16x2, __builtin_amdgcn_cvt_scalef32_pk_f16_fp4(w_, 1.0f, 1)), c2_, acc2[4 * q + 1]); \
                acc2[4 * q + 2] = __builtin_elementwise_fma(__builtin_bit_cast(h16x2, __builtin_amdgcn_cvt_scalef32_pk_f16_fp4(w_, 1.0f, 2)), c2_, acc2[4 * q + 2]); \
                acc2[4 * q + 3] = __builtin_elementwise_fma(__builtin_bit_cast(h16x2, __builtin_amdgcn_cvt_scalef32_pk_f16_fp4(w_, 1.0f, 3)), c2_, acc2[4 * q + 3]); } } } while (0)
#define V_CL(T) ((T) < tlast ? (T) : tlast)
    int t = tfirst;
    int bcur_ = -1; f32x4 gt0 = (f32x4){0.f, 0.f, 0.f, 0.f}, gt1 = gt0;
    V_IDS(t, C0);
    { const int t1 = V_CL(t + stride); V_IDS(t1, C1); }
    V_LOADH(HA, C0, 0);
    for (int it2 = 0; it2 < niter; ++it2) {
        const int t2 = V_CL(t + 2 * stride);
        V_LOADH(HB, C0, 1);
        V_IDS(t2, C2);
        const u32x4 xr_ = __builtin_bit_cast(u32x4, __builtin_amdgcn_raw_buffer_load_b128(xrs, x_lane, t * (DM * 2), 0));
        h16x2 acc2[16];
#pragma unroll
        for (int k = 0; k < 16; ++k) acc2[k] = (h16x2){(_Float16)0.f, (_Float16)0.f};
        V_COMP(HA, C0, 0);
        V_LOADH(HA, C1, 0);
        V_COMP(HB, C0, 1);
#pragma unroll
        for (int k = 0; k < 8; ++k) {
            const auto r_ = __builtin_amdgcn_permlane32_swap(__builtin_bit_cast(unsigned, acc2[k]), __builtin_bit_cast(unsigned, acc2[k + 8]), false, false);
            const unsigned r0_ = r_[0], r1_ = r_[1];
            acc2[k] = __builtin_bit_cast(h16x2, r0_) + __builtin_bit_cast(h16x2, r1_);
        }
#pragma unroll
        for (int k = 0; k < 4; ++k) {
            const auto r_ = __builtin_amdgcn_permlane16_swap(__builtin_bit_cast(unsigned, acc2[k]), __builtin_bit_cast(unsigned, acc2[k + 4]), false, false);
            const unsigned r0_ = r_[0], r1_ = r_[1];
            acc2[k] = __builtin_bit_cast(h16x2, r0_) + __builtin_bit_cast(h16x2, r1_);
        }
        float acc[8];
#pragma unroll
        for (int k = 0; k < 4; ++k) {
            const unsigned o_ = (unsigned)__builtin_amdgcn_update_dpp(0, (int)__builtin_bit_cast(unsigned, acc2[k]), 0x128, 0xf, 0xf, true);
            const h16x2 s_ = acc2[k] + __builtin_bit_cast(h16x2, o_);
            acc[2 * k] = (float)s_[0]; acc[2 * k + 1] = (float)s_[1];
        }
        if ((t >> 14) != bcur_) { bcur_ = t >> 14; gt0 = *(const f32x4*)(modv + bcur_ * 6144); gt1 = *(const f32x4*)(modv + bcur_ * 6144 + 4); }
        f32x4 xv0 = (f32x4){bf_lo(xr_[0]), bf_hi(xr_[0]), bf_lo(xr_[1]), bf_hi(xr_[1])}, xv1 = (f32x4){bf_lo(xr_[2]), bf_hi(xr_[2]), bf_lo(xr_[3]), bf_hi(xr_[3])};
#pragma unroll
        for (int k = 0; k < 4; ++k) { xv0[k] += gt0[k] * acc[k]; xv1[k] += gt1[k] * acc[k + 4]; }
        if (LAST) {
            __builtin_amdgcn_raw_buffer_store_b128(__builtin_bit_cast(u32x4, xv0), ors, o_lane, t * (DM * 4), 0);
            __builtin_amdgcn_raw_buffer_store_b128(__builtin_bit_cast(u32x4, xv1), ors, (o_lane == 0xffffffffu) ? o_lane : o_lane + 16u, t * (DM * 4), 0);
        } else {
            __builtin_amdgcn_raw_buffer_store_b128(__builtin_bit_cast(u32x4, (u32x4){cvt_pk_bf16(xv0[0], xv0[1]), cvt_pk_bf16(xv0[2], xv0[3]), cvt_pk_bf16(xv1[0], xv1[1]), cvt_pk_bf16(xv1[2], xv1[3])}), xrs, x_lane, t * (DM * 2), 0);
        }
#pragma unroll
        for (int q = 0; q < 4; ++q) { C0[q] = C1[q]; C1[q] = C2[q]; }
        t += stride;
    }
#undef V_IDS
#undef V_LOADH
#undef V_COMP
#undef V_CL
}

#ifndef PROBE_MASK
#define PROBE_MASK 0u
#endif
#if USE_CG
#define GRID_BARRIER() cg::this_grid().sync()
#else
#define GRID_BARRIER() xcd_barrier(xb)
#endif
#define PHASE_END(n) do { GRID_BARRIER(); if (PROBE_MASK) { const unsigned long long now_ = __builtin_amdgcn_s_memrealtime(); if ((PROBE_MASK >> (n)) & 1u) probe_dt += now_ - t_prev; t_prev = now_; } } while (0)

__global__ void __launch_bounds__(512, 2) fwd_megakernel(Params p) {
    __shared__ __attribute__((aligned(16))) unsigned char lds_all[LDS_BYTES];
    if (threadIdx.x == 0) { *(u32x4*)(lds_all + LDS_XB_OFF) = (u32x4){0u, 0u, 0u, 0u}; }
    __syncthreads();
    XcdBarrier xb = xcd_barrier_post((unsigned*)(p.ws + WS_BAR), (volatile LAS unsigned*)(lds_all + LDS_XB_OFF));
    unsigned char* lds = lds_all + __builtin_amdgcn_readfirstlane((int)(threadIdx.x >> 8)) * LDS_HALF;
    unsigned char* ws = p.ws;
    const float* modv = (const float*)(ws + WS_MODV);
    bf16_t* A0 = (bf16_t*)(ws + WS_A0);
    bf16_t* XS = (bf16_t*)(ws + WS_XS);
    unsigned long long t_prev = PROBE_MASK ? __builtin_amdgcn_s_memrealtime() : 0ull, probe_dt = 0ull;

    phase0(p, lds);
    PHASE_END(0);
    const SliceMap sm = peer_slice_map(xb);
    SliceMap8 s8; s8.j = sm.j; s8.rank = sm.rank >> 1; s8.nb = sm.nb >> 1;
    const float sw_in = f8_weight_scale(WS_F8WORD(0)), sw_cin = f8_weight_scale(WS_F8WORD(1));
    for (int t = vbid(); t < (H0LD / 64) * 16; t += nvb()) transpose_tile_f8(p.ab_w_in, ws + WS_WIN_T, 1024, 1184, sw_in, t, (float*)lds);
    for (int t = vbid(); t < (3072 / 64) * 16; t += nvb()) transpose_tile_f8(p.c_w_in, ws + WS_CIN_T, 1024, 3072, sw_cin, t, (float*)lds, true);
    rowmod_phase<false, true>(p, p.x, p.ctx, p.norm_mix, 0, 0, A0, MROWS, nullptr);
    PHASE_END(1);
    {
        GemmArgs g{}; g.A = A0; g.lda = 512; g.Bt = (const bf16_t*)(ws + WS_WIN_T); g.ldb = 512; g.K = 512;
        g.C = (bf16_t*)(ws + WS_R + R_H0); g.ldc = H0LD; g.colscale = nullptr; g.oscale = 1.0f / (F8_ASCALE * sw_in);
        g.ssq_out = (float*)(ws + WS_R + R_CKVN);
        gemm8f_phase<EPI_BF16>(g, s8, MROWS / 256, H0LD / 256, lds_all);
    }
    PHASE_END(2);
    {
        GemmArgs g{}; g.A = (const bf16_t*)(ws + WS_R + R_H0); g.lda = H0LD; g.Bt = (const bf16_t*)(ws + WS_QB_T); g.ldb = 384; g.K = 384;
        g.C = (bf16_t*)(ws + WS_R + R_Q); g.ldc = 768; g.colscale = nullptr;
        GemmArgs g2{}; g2.A = (const bf16_t*)(ws + WS_R + R_H0) + 384; g2.lda = H0LD; g2.Bt = (const bf16_t*)(ws + WS_KVB_T); g2.ldb = 256; g2.K = 256;
        g2.C = A0; g2.ldc = 1024; g2.colscale = nullptr;
        g.rowss = (const float*)(ws + WS_R + R_CKVN); g.ss_a = 0; g.ss_b = 1;
        g2.rowss = g.rowss; g2.ss_a = 2; g2.ss_b = 3;
        gemm8_pair_phase(g, NTOK / 256, 3, g2, MROWS / 256, 4, s8, lds_all);
    }
    PHASE_END(4);
    qkv_post_phase(p, lds);
    PHASE_END(5);
#ifdef PROBE_QK_CHECK
    qk_selfcheck(p, (unsigned*)(ws + WS_BAR) + 4001);
    GRID_BARRIER();
#endif
    {
        for (int t = vbid(); t < 4 * (NTOK / 128); t += nvb()) {
            const int grp = t & 3, tm = t >> 2;
            GemmArgs g{}; g.A = (const bf16_t*)(ws + WS_R + R_HQN) + grp * 128; g.lda = 512; g.Bt = (const bf16_t*)(ws + WS_POOL_T) + grp * 128 * 128; g.ldb = 128; g.K = 128;
            g.C = (bf16_t*)(ws + WS_R + R_H0) + 512 + grp * 128; g.ldc = 1024; g.colscale = p.pool_scale + grp * 128;
            gemm_tile<EPI_BF16>(g, tm, 0, lds);
        }
    }
    __syncthreads();
    attention_phase(p, lds_all);
    PHASE_END(7);
#ifdef PROBE_ATTN_CHECK
    attn_selfcheck(p, (unsigned*)(ws + WS_BAR) + 4000);
    GRID_BARRIER();
#endif
    {
        GemmArgs g{}; g.A = (const bf16_t*)(ws + WS_R + R_H0); g.lda = 1024; g.Bt = (const bf16_t*)(ws + WS_WOUT_T); g.ldb = 1024; g.K = 1024;
        g.xin = p.x; g.xs = XS; g.gate = modv + 2 * 1024; g.gate_bstride = 6144;
        gemm8_phase<EPI_RESID, false>(g, s8, NTOK / 256, 4, lds_all);
    }
    PHASE_END(8);
    rowmod_phase<true>(p, XS, p.ctx, p.norm_ffn, 0, 3, A0, NTOK, ws + WS_XQ8);
    PHASE_END(9);
    {
        GemmArgs g{}; g.A = A0; g.lda = 1024; g.Bt = (const bf16_t*)(ws + WS_WQ_T); g.ldb = 1024; g.K = 1024;
        g.C = (bf16_t*)(ws + WS_R + R_Q); g.ldc = 1024; g.colscale = nullptr;
        gemm8_phase<EPI_BF16, false>(g, s8, NTOK / 256, 4, lds_all);
    }
    PHASE_END(10);
    peer_topk_phase(p, 0, (const bf16_t*)(ws + WS_R + R_Q), (int*)(ws + WS_R + R_VT), (float*)(ws + WS_R + R_VT + 16777216ull), lds);
    PHASE_END(11);
    peer_u_phase(p, sm, 0, (const int*)(ws + WS_R + R_VT), (float*)(ws + WS_R + R_H0));
    PHASE_END(12);
    peer_c_phase(p, 0, (const float*)(ws + WS_R + R_H0), (const int*)(ws + WS_R + R_VT), (float*)(ws + WS_R + R_VT + 16777216ull));
    PHASE_END(20);
    peer_v_phase<false>(p, sm, 0, (const unsigned*)(ws + WS_R + R_VT + 16777216ull), XS, p.out);
    PHASE_END(21);
    rowmod_phase<true, true>(p, XS, p.ctx, p.norm_mix + 1024, 1, 0, A0, NTOK, nullptr);
    PHASE_END(13);
    {
        GemmArgs g{}; g.A = A0; g.lda = 512; g.Bt = (const bf16_t*)(ws + WS_CIN_T); g.ldb = 512; g.K = 512;
        g.C = (bf16_t*)(ws + WS_R + R_H1); g.ldc = 3072; g.colscale = nullptr; g.oscale = 1.0f / (F8_ASCALE * sw_cin); g.cv_from = 4;
        gemm8f_phase<EPI_BF16>(g, s8, NTOK / 256, 12, lds_all);
    }
    PHASE_END(14);
    conv_phase(p);
    PHASE_END(15);
    {
        GemmArgs g{}; g.A = (const bf16_t*)(ws + WS_R + R_Z); g.lda = 1024; g.Bt = (const bf16_t*)(ws + WS_COUT_T); g.ldb = 1024; g.K = 1024;
        g.xin = nullptr; g.xs = XS; g.gate = modv + 3 * 6144 + 2 * 1024; g.gate_bstride = 6144;
        gemm8_phase<EPI_RESIDB, false>(g, s8, NTOK / 256, 4, lds_all);
    }
    PHASE_END(16);
    rowmod_phase<true>(p, XS, p.ctx, p.norm_ffn + 1024, 1, 3, A0, NTOK, ws + WS_XQ8);
    PHASE_END(17);
    {
        GemmArgs g{}; g.A = A0; g.lda = 1024; g.Bt = (const bf16_t*)(ws + WS_WQ_T) + 1024 * 1024; g.ldb = 1024; g.K = 1024;
        g.C = (bf16_t*)(ws + WS_R + R_H1); g.ldc = 1024; g.colscale = nullptr;
        gemm8_phase<EPI_BF16, false>(g, s8, NTOK / 256, 4, lds_all);
    }
    PHASE_END(18);
    peer_topk_phase(p, 1, (const bf16_t*)(ws + WS_R + R_H1), (int*)(ws + WS_R + 67108864ull), (float*)(ws + WS_R + 67108864ull + 16777216ull), lds);
    PHASE_END(19);
    peer_u_phase(p, sm, 1, (const int*)(ws + WS_R + 67108864ull), (float*)(ws + WS_R + 100663296ull));
    PHASE_END(22);
    peer_c_phase(p, 1, (const float*)(ws + WS_R + 100663296ull), (const int*)(ws + WS_R + 67108864ull), (float*)(ws + WS_R + 67108864ull + 16777216ull));
    PHASE_END(23);
    peer_v_phase<true>(p, sm, 1, (const unsigned*)(ws + WS_R + 67108864ull + 16777216ull), XS, p.out);
#if defined(PROBE_ATTN_CHECK) || defined(PROBE_QK_CHECK)
    GRID_BARRIER();
    if ((xb_ld((unsigned*)(ws + WS_BAR) + 4000) | xb_ld((unsigned*)(ws + WS_BAR) + 4001)) != 0u && blockIdx.x == 0) { for (int i = threadIdx.x; i < 65536; i += 512) p.out[i] = __uint_as_float(0x7fc00000u); }
#endif
    if (PROBE_MASK) {
        PHASE_END(24);
        if (blockIdx.x == 0 && threadIdx.x == 0) { const unsigned long long t0 = __builtin_amdgcn_s_memrealtime(); while (__builtin_amdgcn_s_memrealtime() - t0 < probe_dt) __builtin_amdgcn_s_sleep(8); }
    }
}

extern "C" void kernel_launch(void* const* d_in, const int* in_sizes, int n_in, void* d_out, int out_size, void* d_ws, size_t ws_size, hipStream_t stream) {
    static int grid = 0;
    if (grid == 0) {
        if (n_in != 25 || out_size != NTOK * DM || ws_size < WS_TOTAL) {
            fprintf(stderr, "kernel_launch: unexpected sizes (n_in %d, out %d, ws %zu, need %llu)\n", n_in, out_size, ws_size, (unsigned long long)WS_TOTAL);
            grid = -1; return;
        }
        int dev = 0, cus = 0, per_cu = 0;
        (void)hipGetDevice(&dev);
        (void)hipDeviceGetAttribute(&cus, hipDeviceAttributeMultiprocessorCount, dev);
        if (hipOccupancyMaxActiveBlocksPerMultiprocessor(&per_cu, (const void*)fwd_megakernel, 512, 0) != hipSuccess || per_cu < 1) { fprintf(stderr, "kernel_launch: occupancy query failed\n"); grid = -1; return; }
        if (per_cu > 1) per_cu = 1;
        grid = cus * per_cu;
    }
    if (grid < 0) return;
    Params p{};
    const float** f = (const float**)&p.x;
    for (int i = 0; i < 25; ++i) f[i] = (const float*)d_in[i];
    p.out = (float*)d_out; p.ws = (unsigned char*)d_ws;
    (void)hipMemsetAsync(d_ws, 0, 16384, stream);
#if USE_CG
    void* args[] = {&p};
    hipError_t e = hipLaunchCooperativeKernel((const void*)fwd_megakernel, dim3(grid), dim3(512), args, 0, stream);
    if (e != hipSuccess) fprintf(stderr, "cooperative launch failed: %s (grid %d)\n", hipGetErrorString(e), grid);
#else
    hipLaunchKernelGGL(fwd_megakernel, dim3(grid), dim3(512), 0, stream, p);
#endif
}
```
